# Optimizing an MI355X kernel written in HIP

```python
import math
import jax, jax.numpy as jnp
from jax import lax
import numpy as np

D_MODEL = 1024
BATCH = 16
SEQ = 2048
DEPTH = 1

PLE_DIM = 256
HEAD_DIM = 64
ATTN_WIDTH = D_MODEL // 2
ATTN_HEADS = ATTN_WIDTH // HEAD_DIM
SSM_WIDTH = D_MODEL - ATTN_WIDTH
SSM_GROUP = 16
SSM_GROUPS = SSM_WIDTH // SSM_GROUP
SSM_STATE = 64
MIX_WIDTH = ATTN_WIDTH + SSM_WIDTH
IN_WIDTH = 4 * ATTN_WIDTH + 2 * SSM_WIDTH
DILATED_CONFIGS = ((128, 1), (512, 4), (2048, 16))
BLOCK_Q = 128
EPS = 1e-6
DT_MIN = 1e-3
DT_MAX = 1e-1

kernel_name = "hymba_s5_longnet_hybrid"


def rms_norm(x, gain):
    xf = x.astype(jnp.float32)
    y = xf * lax.rsqrt(jnp.mean(xf * xf, axis=-1, keepdims=True) + EPS) * gain.astype(jnp.float32)
    return y.astype(x.dtype)


def banded_causal_attention(q, k, v, w):
    n, l, dh = q.shape
    nb = -(-l // BLOCK_Q)
    lp = nb * BLOCK_Q
    nk = BLOCK_Q + w
    qb = jnp.pad(q, ((0, 0), (0, lp - l), (0, 0))).reshape(n, nb, BLOCK_Q, dh)
    kp = jnp.pad(k, ((0, 0), (w, lp - l), (0, 0)))
    vp = jnp.pad(v, ((0, 0), (w, lp - l), (0, 0)))
    block_start = jnp.arange(nb) * BLOCK_Q
    idx = block_start[:, None] + jnp.arange(nk)[None, :]
    kb = kp[:, idx]
    vb = vp[:, idx]
    s = jnp.einsum('nbqd,nbkd->nbqk', qb, kb)
    qi = jnp.arange(BLOCK_Q)[:, None]
    kj = jnp.arange(nk)[None, :]
    key_pos = block_start[:, None, None] + kj[None] - w
    valid = (kj >= qi)[None] & (kj <= qi + w)[None] & (key_pos >= 0)
    s = jnp.where(valid[None], s, -jnp.inf)
    m = jnp.max(s, axis=-1, keepdims=True)
    e = jnp.exp(s - m)
    den = jnp.sum(e, axis=-1)
    o = jnp.einsum('nbqk,nbkd->nbqd', e, vb) / den[..., None]
    lse = m[..., 0] + jnp.log(den)
    return o.reshape(n, lp, dh)[:, :l], lse.reshape(n, lp)[:, :l]


def dilated_window_attention(q, k, v, window, dilation):
    b, s, h, dh = q.shape
    l = s // dilation
    w = window // dilation

    def to_classes(t):
        return t.reshape(b, l, dilation, h, dh).transpose(0, 2, 3, 1, 4).reshape(b * dilation * h, l, dh)

    o, lse = banded_causal_attention(to_classes(q), to_classes(k), to_classes(v), w)
    o = o.reshape(b, dilation, h, l, dh).transpose(0, 3, 1, 2, 4).reshape(b, s, h, dh)
    lse = lse.reshape(b, dilation, h, l).transpose(0, 3, 1, 2).reshape(b, s, h)
    return o, lse


def dilated_mixture_attention(q, k, v, q_gain, k_gain):
    b, s, _ = q.shape

    def heads(t):
        return t.reshape(b, s, ATTN_HEADS, HEAD_DIM).astype(jnp.float32)

    qh = rms_norm(heads(q), q_gain) * (HEAD_DIM ** -0.5)
    kh = rms_norm(heads(k), k_gain)
    vh = heads(v)
    outs, lses = [], []
    for window, dilation in DILATED_CONFIGS:
        o, lse = dilated_window_attention(qh, kh, vh, window, dilation)
        outs.append(o)
        lses.append(lse)
    wts = jax.nn.softmax(jnp.stack(lses), axis=0)
    o = jnp.sum(wts[..., None] * jnp.stack(outs), axis=0)
    return o.reshape(b, s, ATTN_WIDTH).astype(q.dtype)


def s5_glu(u, lam_re, lam_im, log_dt, b_re, b_im, c_re, c_im, d_skip, w_glu, b_glu):
    f32 = jnp.float32
    bsz, s, _ = u.shape
    uf = u.astype(f32)
    ug = uf.reshape(bsz, s, SSM_GROUPS, SSM_GROUP)
    lam_re = lam_re.astype(f32); lam_im = lam_im.astype(f32)
    dt = jnp.exp(log_dt.astype(f32))[:, None]
    mag = jnp.exp(lam_re * dt)
    a_re = mag * jnp.cos(lam_im * dt)
    a_im = mag * jnp.sin(lam_im * dt)
    den = lam_re * lam_re + lam_im * lam_im
    num_re = a_re - 1.0
    coef_re = (num_re * lam_re + a_im * lam_im) / den
    coef_im = (a_im * lam_re - num_re * lam_im) / den
    b_re = b_re.astype(f32); b_im = b_im.astype(f32)
    bb_re = coef_re[..., None] * b_re - coef_im[..., None] * b_im
    bb_im = coef_re[..., None] * b_im + coef_im[..., None] * b_re
    bu_re = jnp.einsum('bsgc,gnc->bsgn', ug, bb_re)
    bu_im = jnp.einsum('bsgc,gnc->bsgn', ug, bb_im)
    ar = jnp.broadcast_to(a_re, bu_re.shape)
    ai = jnp.broadcast_to(a_im, bu_re.shape)

    def combine(left, right):
        ar1, ai1, br1, bi1 = left
        ar2, ai2, br2, bi2 = right
        return (ar2 * ar1 - ai2 * ai1,
                ar2 * ai1 + ai2 * ar1,
                ar2 * br1 - ai2 * bi1 + br2,
                ar2 * bi1 + ai2 * br1 + bi2)

    _, _, xr, xi = lax.associative_scan(combine, (ar, ai, bu_re, bu_im), axis=1)
    y = (jnp.einsum('bsgn,gcn->bsgc', xr, c_re.astype(f32))
         - jnp.einsum('bsgn,gcn->bsgc', xi, c_im.astype(f32))).reshape(bsz, s, SSM_WIDTH)
    y = y + d_skip.astype(f32) * uf
    yg = jax.nn.gelu(y, approximate=False)
    out = yg * jax.nn.sigmoid(yg @ w_glu.astype(f32) + b_glu.astype(f32))
    return out.astype(u.dtype)


def setup_inputs(seed: int = 0) -> dict:
    key = jax.random.key(seed)
    ks = jax.random.split(key, 24)
    f32 = jnp.float32
    nrm = lambda k, shape, scale: jax.random.normal(k, shape, f32) * scale
    x = nrm(ks[0], (BATCH, SEQ, D_MODEL), 1.0)
    p = nrm(ks[1], (DEPTH, BATCH, SEQ, PLE_DIM), 1.0)
    mix_norm = 1.0 + nrm(ks[2], (DEPTH, D_MODEL), 0.02)
    w_in = nrm(ks[3], (DEPTH, D_MODEL, IN_WIDTH), D_MODEL ** -0.5)
    q_norm = 1.0 + nrm(ks[4], (DEPTH, HEAD_DIM), 0.02)
    k_norm = 1.0 + nrm(ks[5], (DEPTH, HEAD_DIM), 0.02)
    n_idx = jnp.arange(SSM_STATE, dtype=f32)
    lambda_re = -0.5 + nrm(ks[6], (DEPTH, SSM_GROUPS, SSM_STATE), 0.01)
    lambda_im = math.pi * n_idx + nrm(ks[7], (DEPTH, SSM_GROUPS, SSM_STATE), 0.01)
    log_dt = jax.random.uniform(ks[8], (DEPTH, SSM_GROUPS), f32, math.log(DT_MIN), math.log(DT_MAX))
    b_re = nrm(ks[9], (DEPTH, SSM_GROUPS, SSM_STATE, SSM_GROUP), (2.0 * SSM_GROUP) ** -0.5)
    b_im = nrm(ks[10], (DEPTH, SSM_GROUPS, SSM_STATE, SSM_GROUP), (2.0 * SSM_GROUP) ** -0.5)
    c_re = nrm(ks[11], (DEPTH, SSM_GROUPS, SSM_GROUP, SSM_STATE), (2.0 * SSM_STATE) ** -0.5)
    c_im = nrm(ks[12], (DEPTH, SSM_GROUPS, SSM_GROUP, SSM_STATE), (2.0 * SSM_STATE) ** -0.5)
    d_skip = nrm(ks[13], (DEPTH, SSM_WIDTH), 1.0)
    w_glu = nrm(ks[14], (DEPTH, SSM_WIDTH, SSM_WIDTH), SSM_WIDTH ** -0.5)
    b_glu = nrm(ks[15], (DEPTH, SSM_WIDTH), 0.02)
    w_out = nrm(ks[16], (DEPTH, MIX_WIDTH, D_MODEL), MIX_WIDTH ** -0.5)
    ple_norm = 1.0 + nrm(ks[17], (DEPTH, D_MODEL), 0.02)
    w_ple_gate = nrm(ks[18], (DEPTH, D_MODEL, D_MODEL), D_MODEL ** -0.5)
    w_ple_proj = nrm(ks[19], (DEPTH, PLE_DIM, D_MODEL), PLE_DIM ** -0.5)
    return {"x": x, "p": p, "mix_norm": mix_norm, "w_in": w_in, "q_norm": q_norm,
            "k_norm": k_norm, "lambda_re": lambda_re, "lambda_im": lambda_im, "log_dt": log_dt,
            "b_re": b_re, "b_im": b_im, "c_re": c_re, "c_im": c_im, "d_skip": d_skip,
            "w_glu": w_glu, "b_glu": b_glu, "w_out": w_out, "ple_norm": ple_norm,
            "w_ple_gate": w_ple_gate, "w_ple_proj": w_ple_proj}


def reference(x, p, mix_norm, w_in, q_norm, k_norm, lambda_re, lambda_im, log_dt,
              b_re, b_im, c_re, c_im, d_skip, w_glu, b_glu, w_out, ple_norm,
              w_ple_gate, w_ple_proj):
    A = ATTN_WIDTH
    splits = [A, 2 * A, 3 * A, 4 * A, 4 * A + SSM_WIDTH]
    h = x
    for i in range(DEPTH):
        xn = rms_norm(h, mix_norm[i])
        z = xn @ w_in[i]
        q, k, v, gate_a, u, gate_s = jnp.split(z, splits, axis=-1)
        attn = dilated_mixture_attention(q, k, v, q_norm[i], k_norm[i]) * jax.nn.silu(gate_a)
        ssm = s5_glu(u, lambda_re[i], lambda_im[i], log_dt[i], b_re[i], b_im[i], c_re[i],
                     c_im[i], d_skip[i], w_glu[i], b_glu[i]) * jax.nn.silu(gate_s)
        h = h + jnp.concatenate([attn, ssm], axis=-1) @ w_out[i]
        gate = jax.nn.sigmoid(rms_norm(h, ple_norm[i]) @ w_ple_gate[i])
        h = h + gate * (p[i] @ w_ple_proj[i])
    return h
```

```cpp
#include <hip/hip_runtime.h>
#include <hip/hip_cooperative_groups.h>
#include <cstdio>
#include <cstdint>
namespace cg = cooperative_groups;

#ifndef N_LAUNCH
#define N_LAUNCH 8
#endif

typedef unsigned short bf16_t;
typedef short bf16x8 __attribute__((ext_vector_type(8)));
typedef float f32x4 __attribute__((ext_vector_type(4)));
typedef unsigned u32x4 __attribute__((ext_vector_type(4)));

constexpr int NB = 16, SEQ = 2048, DM = 1024, T = NB * SEQ, AW = 512, NH = 8, HD = 64, NG = 32, NS = 64, GC = 16, PLE = 256, INW = 3072;
constexpr float EPS = 1e-6f;
constexpr float QSCALE = 0.125f * 1.4426950408889634f;

constexpr size_t MiB = 1u << 20;
constexpr size_t WS_CTL = 0;
constexpr size_t WS_WINT = 1 * MiB, WS_WGLUT = 7 * MiB, WS_WOUTT = 8 * MiB, WS_WGT = 10 * MiB, WS_WPT = 12 * MiB;
constexpr size_t WS_RRMSX = 13 * MiB, WS_RRMSH = 13 * MiB + 256 * 1024, WS_SSPART = 13 * MiB + 512 * 1024;
constexpr size_t WS_DEN = 14 * MiB;
constexpr size_t WS_XB = 32 * MiB, WS_HB = 32 * MiB;
constexpr size_t WS_PB = 96 * MiB;
constexpr size_t WS_Q = 112 * MiB, WS_K = 144 * MiB, WS_V = 176 * MiB, WS_MIX = 144 * MiB;
constexpr size_t WS_GA = 208 * MiB, WS_GS = 240 * MiB, WS_U = 272 * MiB;
constexpr size_t WS_NUM = 304 * MiB, WS_PROJ = 304 * MiB;
constexpr size_t WS_YG = 400 * MiB, WS_END = 432 * MiB;

struct Params { const float* in[20]; float* out; unsigned char* ws; int ph_lo; int ph_hi; };

__device__ __forceinline__ unsigned f2bf(float f) { unsigned u = __float_as_uint(f); return (u + 0x7fffu + ((u >> 16) & 1u)) >> 16; }
__device__ __forceinline__ float bf2f(unsigned b) { return __uint_as_float(b << 16); }
__device__ __forceinline__ unsigned pk2(float lo, float hi) { return f2bf(lo) | (f2bf(hi) << 16); }
__device__ __forceinline__ float bflo(unsigned w) { return __uint_as_float(w << 16); }
__device__ __forceinline__ float bfhi(unsigned w) { return __uint_as_float(w & 0xffff0000u); }
__device__ __forceinline__ float wave_sum(float v) {
#pragma unroll
    for (int o = 1; o < 64; o <<= 1) v += __shfl_xor(v, o);
    return v;
}
__device__ __forceinline__ float silu_f(float v) { return v / (1.f + __expf(-v)); }
__device__ __forceinline__ float sigmoid_f(float v) { return 1.f / (1.f + __expf(-v)); }
__device__ __forceinline__ int pi_col(int p) { const int t = p >> 8, w = p & 255, bj = w >> 7, wc = (w >> 5) & 3, i = w & 31; return (t << 8) + (wc << 6) + (bj << 5) + i; }

struct Ctx { int gtid, nthr, gwave, nwaves, lane; };

__device__ void ph_prep(const Params& P, const Ctx& c) {
    unsigned char* ws = P.ws;
    const float* w_in = P.in[3]; const float* mixn = P.in[2];
    bf16_t* WinT = (bf16_t*)(ws + WS_WINT);
    for (size_t i = c.gtid; i < (size_t)INW * DM; i += c.nthr) { const int p = (int)(i >> 10), k = (int)(i & 1023); WinT[i] = (bf16_t)f2bf(w_in[(size_t)k * INW + pi_col(p)] * mixn[k]); }
    const float* w_glu = P.in[14]; bf16_t* WgluT = (bf16_t*)(ws + WS_WGLUT);
    for (size_t i = c.gtid; i < (size_t)512 * 512; i += c.nthr) { const int n = (int)(i >> 9), k = (int)(i & 511); WgluT[i] = (bf16_t)f2bf(w_glu[(size_t)k * 512 + n]); }
    const float* w_out = P.in[16]; const float* w_g = P.in[18]; const float* plen = P.in[17];
    bf16_t* WoutT = (bf16_t*)(ws + WS_WOUTT); bf16_t* WgT = (bf16_t*)(ws + WS_WGT);
    for (size_t i = c.gtid; i < (size_t)DM * DM; i += c.nthr) { const int n = (int)(i >> 10), k = (int)(i & 1023);
        WoutT[i] = (bf16_t)f2bf(w_out[(size_t)k * DM + n]); WgT[i] = (bf16_t)f2bf(w_g[(size_t)k * DM + n] * plen[k]); }
    const float* w_p = P.in[19]; bf16_t* WpT = (bf16_t*)(ws + WS_WPT);
    for (size_t i = c.gtid; i < (size_t)DM * PLE; i += c.nthr) { const int n = (int)(i >> 8), k = (int)(i & 255); WpT[i] = (bf16_t)f2bf(w_p[(size_t)k * DM + n]); }
    const float* x = P.in[0]; bf16_t* XB = (bf16_t*)(ws + WS_XB); float* rr = (float*)(ws + WS_RRMSX);
    for (int row = c.gwave; row < T; row += c.nwaves) {
        const f32x4* xr = (const f32x4*)(x + (size_t)row * DM) + c.lane;
        f32x4 v[4]; float s = 0.f;
#pragma unroll
        for (int j = 0; j < 4; ++j) { v[j] = xr[64 * j]; s += (v[j].x * v[j].x + v[j].y * v[j].y) + (v[j].z * v[j].z + v[j].w * v[j].w); }
        s = wave_sum(s);
        if (c.lane == 0) rr[row] = 1.0f / sqrtf(s * (1.f / DM) + EPS);
        unsigned long long* o8 = (unsigned long long*)(XB + (size_t)row * DM) + c.lane;
#pragma unroll
        for (int j = 0; j < 4; ++j) o8[64 * j] = (unsigned long long)pk2(v[j].x, v[j].y) | ((unsigned long long)pk2(v[j].z, v[j].w) << 32);
    }
    const float* p = P.in[1]; bf16_t* PB = (bf16_t*)(ws + WS_PB);
    for (size_t i = c.gtid; i < (size_t)T * PLE / 4; i += c.nthr) { const f32x4 v = ((const f32x4*)p)[i]; ((unsigned long long*)PB)[i] = (unsigned long long)pk2(v.x, v.y) | ((unsigned long long)pk2(v.z, v.w) << 32); }
}

template <class Epi>
__device__ __forceinline__ void ngemm(const bf16_t* A, const bf16_t* Bt, int M, int N, int K, const Ctx& c, const Epi& epi) {
    const int fr = c.lane & 15, fq = c.lane >> 4;
    const int tilesM = M / 16, tilesN = N / 256;
    for (int t = c.gwave; t < tilesM * tilesN; t += c.nwaves) {
        const int tn = t / tilesM, tm = t % tilesM;
        f32x4 acc[16];
#pragma unroll
        for (int i = 0; i < 16; ++i) acc[i] = (f32x4){0.f, 0.f, 0.f, 0.f};
        const bf16_t* ap = A + (size_t)(tm * 16 + fr) * K + fq * 8;
        const bf16_t* bp = Bt + (size_t)(tn * 256 + fr) * K + fq * 8;
        for (int k = 0; k < K; k += 32) {
            const bf16x8 a = *(const bf16x8*)(ap + k);
#pragma unroll
            for (int nt = 0; nt < 16; ++nt) { const bf16x8 b = *(const bf16x8*)(bp + (size_t)nt * 16 * K + k); acc[nt] = __builtin_amdgcn_mfma_f32_16x16x32_bf16(a, b, acc[nt], 0, 0, 0); }
        }
#pragma unroll
        for (int nt = 0; nt < 16; ++nt)
#pragma unroll
            for (int r = 0; r < 4; ++r) epi(tm * 16 + 4 * fq + r, tn * 256 + nt * 16 + fr, acc[nt][r]);
    }
}

struct EpiInProj {
    const float* rr; bf16_t *Q, *K, *V, *GA, *GS, *U;
    __device__ __forceinline__ void operator()(int row, int pcol, float v) const {
        const int lc = pi_col(pcol), seg = lc >> 9, cc = lc & 511; v *= rr[row];
        if (seg == 0) Q[(size_t)row * AW + cc] = (bf16_t)f2bf(v);
        else if (seg == 1) K[(size_t)row * AW + cc] = (bf16_t)f2bf(v);
        else if (seg == 2) V[(size_t)row * AW + cc] = (bf16_t)f2bf(v);
        else if (seg == 3) GA[(size_t)row * AW + cc] = (bf16_t)f2bf(silu_f(v));
        else if (seg == 4) { const int b = row >> 11, s = row & 2047, g = cc >> 4, ch = cc & 15; U[((size_t)(b * NG + g) * SEQ + s) * GC + ch] = (bf16_t)f2bf(v); }
        else GS[(size_t)row * AW + cc] = (bf16_t)f2bf(silu_f(v));
    }
};
__device__ void ph_inproj(const Params& P, const Ctx& c) {
    unsigned char* ws = P.ws;
    EpiInProj E{(const float*)(ws + WS_RRMSX), (bf16_t*)(ws + WS_Q), (bf16_t*)(ws + WS_K), (bf16_t*)(ws + WS_V), (bf16_t*)(ws + WS_GA), (bf16_t*)(ws + WS_GS), (bf16_t*)(ws + WS_U)};
    ngemm((const bf16_t*)(ws + WS_XB), (const bf16_t*)(ws + WS_WINT), T, INW, DM, c, E);
}
__device__ void ph_qknorm(const Params& P, const Ctx& c) {
    unsigned char* ws = P.ws; const float* qn = P.in[4]; const float* kn = P.in[5];
    for (int it = c.gwave; it < T * NH * 2; it += c.nwaves) {
        const int which = it & 1, h = (it >> 1) & 7, row = it >> 4;
        bf16_t* p = (bf16_t*)(ws + (which ? WS_K : WS_Q)) + (size_t)row * AW + h * HD + c.lane;
        const float v = bf2f(*p); const float ss = wave_sum(v * v);
        const float r = 1.0f / sqrtf(ss * (1.f / HD) + EPS);
        const float g = which ? kn[c.lane] : qn[c.lane] * QSCALE;
        *p = (bf16_t)f2bf(v * r * g);
    }
}
__device__ void ph_attn_naive(const Params& P, const Ctx& c) {
    unsigned char* ws = P.ws;
    const bf16_t* Q = (const bf16_t*)(ws + WS_Q); const bf16_t* K = (const bf16_t*)(ws + WS_K); const bf16_t* V = (const bf16_t*)(ws + WS_V);
    bf16_t* NUM = (bf16_t*)(ws + WS_NUM); float* DEN = (float*)(ws + WS_DEN);
    for (int it = c.gwave; it < 3 * T * NH; it += c.nwaves) {
        const int h = it & 7, rc = it >> 3, row = rc % T, cf = rc / T;
        const int dil = cf == 0 ? 1 : (cf == 1 ? 4 : 16);
        const int s = row & 2047; const size_t rb = (size_t)(row - s);
        const float q = bf2f(Q[(size_t)row * AW + h * HD + c.lane]);
        float acc = 0.f, den = 0.f;
        for (int j = 0; j <= 128; ++j) {
            const int ks = s - j * dil; if (ks < 0) break;
            const size_t off = (rb + ks) * AW + h * HD + c.lane;
            const float sc = wave_sum(q * bf2f(K[off]));
            const float p = exp2f(sc); den += p; acc += p * bf2f(V[off]);
        }
        NUM[((size_t)cf * T + row) * AW + h * HD + c.lane] = (bf16_t)f2bf(acc);
        if (c.lane == 0) DEN[((size_t)cf * T + row) * NH + h] = den;
    }
}
__device__ void ph_ssm_naive(const Params& P, const Ctx& c) {
    unsigned char* ws = P.ws;
    const float* lam_re = P.in[6]; const float* lam_im = P.in[7]; const float* log_dt = P.in[8];
    const float* b_re = P.in[9]; const float* b_im = P.in[10]; const float* c_re = P.in[11]; const float* c_im = P.in[12]; const float* d_skip = P.in[13];
    const bf16_t* U = (const bf16_t*)(ws + WS_U); bf16_t* YG = (bf16_t*)(ws + WS_YG);
    for (int it = c.gwave; it < NB * NG; it += c.nwaves) {
        const int b = it / NG, g = it % NG, n = c.lane;
        const float dt = expf(log_dt[g]), lr = lam_re[g * NS + n], li = lam_im[g * NS + n];
        const float mag = expf(lr * dt); float sn, cs; sincosf(li * dt, &sn, &cs);
        const float ar = mag * cs, ai = mag * sn;
        const float dn = lr * lr + li * li, nr = ar - 1.f;
        const float cr = (nr * lr + ai * li) / dn, ci = (ai * lr - nr * li) / dn;
        float bbr[16], bbi[16], cre[16], cim[16];
#pragma unroll
        for (int ch = 0; ch < 16; ++ch) { const float br = b_re[(size_t)(g * NS + n) * GC + ch], bi = b_im[(size_t)(g * NS + n) * GC + ch];
            bbr[ch] = cr * br - ci * bi; bbi[ch] = cr * bi + ci * br; cre[ch] = c_re[(size_t)(g * GC + ch) * NS + n]; cim[ch] = c_im[(size_t)(g * GC + ch) * NS + n]; }
        const float dsk = d_skip[g * GC + (c.lane & 15)];
        float xr = 0.f, xi = 0.f;
        const bf16_t* up = U + (size_t)(b * NG + g) * SEQ * GC;
        for (int s = 0; s < SEQ; ++s) {
            const u32x4 w0 = *(const u32x4*)(up + (size_t)s * GC), w1 = *(const u32x4*)(up + (size_t)s * GC + 8);
            float uu[16];
#pragma unroll
            for (int j = 0; j < 4; ++j) { uu[2 * j] = bflo(w0[j]); uu[2 * j + 1] = bfhi(w0[j]); uu[8 + 2 * j] = bflo(w1[j]); uu[8 + 2 * j + 1] = bfhi(w1[j]); }
            float bur = 0.f, bui = 0.f;
#pragma unroll
            for (int ch = 0; ch < 16; ++ch) { bur += uu[ch] * bbr[ch]; bui += uu[ch] * bbi[ch]; }
            const float nxr = ar * xr - ai * xi + bur, nxi = ar * xi + ai * xr + bui; xr = nxr; xi = nxi;
            float myy = 0.f, myu = 0.f;
#pragma unroll
            for (int ch = 0; ch < 16; ++ch) { const float tsum = wave_sum(xr * cre[ch] - xi * cim[ch]); if (c.lane == ch) { myy = tsum; myu = uu[ch]; } }
            if (c.lane < 16) { const float y = myy + dsk * myu; const float yg = 0.5f * y * (1.f + erff(y * 0.70710678118654752f));
                YG[(size_t)(b * SEQ + s) * AW + g * GC + c.lane] = (bf16_t)f2bf(yg); }
        }
    }
}
__device__ void ph_merge(const Params& P, const Ctx& c) {
    unsigned char* ws = P.ws;
    const bf16_t* NUM = (const bf16_t*)(ws + WS_NUM); const float* DEN = (const float*)(ws + WS_DEN); const bf16_t* GA = (const bf16_t*)(ws + WS_GA); bf16_t* MIX = (bf16_t*)(ws + WS_MIX);
    for (size_t i = c.gtid; i < (size_t)T * 64; i += c.nthr) {
        const int row = (int)(i >> 6), c8 = (int)(i & 63) * 8, h = c8 >> 6;
        const float den = DEN[(size_t)row * NH + h] + DEN[((size_t)T + row) * NH + h] + DEN[((size_t)2 * T + row) * NH + h];
        const float inv = 1.0f / den;
        const u32x4 n0 = *(const u32x4*)(NUM + (size_t)row * AW + c8), n1 = *(const u32x4*)(NUM + ((size_t)T + row) * AW + c8), n2 = *(const u32x4*)(NUM + ((size_t)2 * T + row) * AW + c8);
        const u32x4 ga = *(const u32x4*)(GA + (size_t)row * AW + c8);
        u32x4 o;
#pragma unroll
        for (int j = 0; j < 4; ++j) { const float lo = (bflo(n0[j]) + bflo(n1[j]) + bflo(n2[j])) * inv * bflo(ga[j]); const float hi = (bfhi(n0[j]) + bfhi(n1[j]) + bfhi(n2[j])) * inv * bfhi(ga[j]); o[j] = pk2(lo, hi); }
        *(u32x4*)(MIX + (size_t)row * DM + c8) = o;
    }
}
struct EpiGlu {
    const float* bglu; const bf16_t* YG; const bf16_t* GS; bf16_t* MIX;
    __device__ __forceinline__ void operator()(int row, int col, float v) const {
        const float yg = bf2f(YG[(size_t)row * AW + col]); const float gs = bf2f(GS[(size_t)row * AW + col]);
        MIX[(size_t)row * DM + AW + col] = (bf16_t)f2bf(yg * sigmoid_f(v + bglu[col]) * gs);
    }
};
__device__ void ph_glu(const Params& P, const Ctx& c) {
    unsigned char* ws = P.ws;
    EpiGlu E{P.in[15], (const bf16_t*)(ws + WS_YG), (const bf16_t*)(ws + WS_GS), (bf16_t*)(ws + WS_MIX)};
    ngemm((const bf16_t*)(ws + WS_YG), (const bf16_t*)(ws + WS_WGLUT), T, AW, AW, c, E);
}
struct EpiOut {
    const float* x; float* H; bf16_t* HB;
    __device__ __forceinline__ void operator()(int row, int col, float v) const { const size_t o = (size_t)row * DM + col; const float h = x[o] + v; H[o] = h; HB[o] = (bf16_t)f2bf(h); }
};
struct EpiProj { bf16_t* PR; __device__ __forceinline__ void operator()(int row, int col, float v) const { PR[(size_t)row * DM + col] = (bf16_t)f2bf(v); } };
__device__ void ph_outproj(const Params& P, const Ctx& c) {
    unsigned char* ws = P.ws;
    EpiOut E{P.in[0], P.out, (bf16_t*)(ws + WS_HB)};
    ngemm((const bf16_t*)(ws + WS_MIX), (const bf16_t*)(ws + WS_WOUTT), T, DM, DM, c, E);
    EpiProj E2{(bf16_t*)(ws + WS_PROJ)};
    ngemm((const bf16_t*)(ws + WS_PB), (const bf16_t*)(ws + WS_WPT), T, DM, PLE, c, E2);
}
__device__ void ph_rrmsh(const Params& P, const Ctx& c) {
    float* rr = (float*)(P.ws + WS_RRMSH);
    for (int row = c.gwave; row < T; row += c.nwaves) {
        const f32x4* xr = (const f32x4*)(P.out + (size_t)row * DM) + c.lane; float s = 0.f;
#pragma unroll
        for (int j = 0; j < 4; ++j) { const f32x4 v = xr[64 * j]; s += (v.x * v.x + v.y * v.y) + (v.z * v.z + v.w * v.w); }
        s = wave_sum(s);
        if (c.lane == 0) rr[row] = 1.0f / sqrtf(s * (1.f / DM) + EPS);
    }
}
struct EpiGate {
    const float* rr; const bf16_t* PR; float* out;
    __device__ __forceinline__ void operator()(int row, int col, float v) const { const size_t o = (size_t)row * DM + col; out[o] = out[o] + sigmoid_f(v * rr[row]) * bf2f(PR[o]); }
};
__device__ void ph_gate(const Params& P, const Ctx& c) {
    unsigned char* ws = P.ws;
    EpiGate E{(const float*)(ws + WS_RRMSH), (const bf16_t*)(ws + WS_PROJ), P.out};
    ngemm((const bf16_t*)(ws + WS_HB), (const bf16_t*)(ws + WS_WGT), T, DM, DM, c, E);
}

constexpr int NPHASE = 8;
__global__ void __launch_bounds__(512, 2) mega(Params P) {
    Ctx c; c.lane = threadIdx.x & 63; c.gtid = blockIdx.x * 512 + threadIdx.x; c.nthr = gridDim.x * 512; c.gwave = c.gtid >> 6; c.nwaves = c.nthr >> 6;
    cg::grid_group grid = cg::this_grid();
    for (int ph = P.ph_lo; ph < P.ph_hi; ++ph) {
        switch (ph) {
            case 0: ph_prep(P, c); break;
            case 1: ph_inproj(P, c); break;
            case 2: ph_qknorm(P, c); break;
            case 3: ph_attn_naive(P, c); ph_ssm_naive(P, c); break;
            case 4: ph_merge(P, c); ph_glu(P, c); break;
            case 5: ph_outproj(P, c); break;
            case 6: ph_rrmsh(P, c); break;
            case 7: ph_gate(P, c); break;
        }
        if (ph + 1 < P.ph_hi) grid.sync();
    }
}

extern "C" void kernel_launch(void* const* d_in, const int* in_sizes, int n_in, void* d_out, int out_size, void* d_ws, size_t ws_size, hipStream_t stream) {
    static int grid = 0;
    if (grid == 0) {
        int dev = 0, cus = 0, per_cu = 0;
        (void)hipGetDevice(&dev); (void)hipDeviceGetAttribute(&cus, hipDeviceAttributeMultiprocessorCount, dev);
        (void)hipOccupancyMaxActiveBlocksPerMultiprocessor(&per_cu, (const void*)mega, 512, 0);
        if (per_cu < 1) per_cu = 1;
        if (per_cu > 2) per_cu = 2;
        grid = cus * per_cu;
        if (n_in != 20 || ws_size < WS_END) { fprintf(stderr, "kernel_launch: unexpected n_in %d / ws %zu\n", n_in, ws_size); }
    }
    Params p{};
    for (int i = 0; i < 20; ++i) p.in[i] = (const float*)d_in[i];
    p.out = (float*)d_out; p.ws = (unsigned char*)d_ws;
#if N_LAUNCH == 1
    p.ph_lo = 0; p.ph_hi = NPHASE;
    void* args[] = {&p};
    hipError_t e = hipLaunchCooperativeKernel((const void*)mega, dim3(grid), dim3(512), args, 0, stream);
    if (e != hipSuccess) fprintf(stderr, "cooperative launch failed: %s (grid %d)\n", hipGetErrorString(e), grid);
#else
    for (int ph = 0; ph < NPHASE; ++ph) { p.ph_lo = ph; p.ph_hi = ph + 1; hipLaunchKernelGGL(mega, dim3(grid), dim3(512), 0, stream, p); }
#endif
}
```

```cpp
#include <hip/hip_runtime.h>
#include <hip/hip_cooperative_groups.h>
#include <cstdio>
#include <cstdint>
namespace cg = cooperative_groups;

#ifndef N_LAUNCH
#define N_LAUNCH 1
#endif

typedef unsigned short bf16_t;
typedef short bf16x8 __attribute__((ext_vector_type(8)));
typedef float f32x4 __attribute__((ext_vector_type(4)));
typedef unsigned u32x4 __attribute__((ext_vector_type(4)));

constexpr int NB = 16, SEQ = 2048, DM = 1024, T = NB * SEQ, AW = 512, NH = 8, HD = 64, NG = 32, NS = 64, GC = 16, PLE = 256, INW = 3072;
constexpr float EPS = 1e-6f;
constexpr float QSCALE = 0.125f * 1.4426950408889634f;

constexpr size_t MiB = 1u << 20;
constexpr size_t WS_CTL = 0;
constexpr size_t WS_WINT = 1 * MiB, WS_WGLUT = 7 * MiB, WS_WOUTT = 8 * MiB, WS_WGT = 10 * MiB, WS_WPT = 12 * MiB;
constexpr size_t WS_RRMSX = 13 * MiB, WS_RRMSH = 13 * MiB + 256 * 1024;
constexpr size_t WS_DEN = 14 * MiB;
constexpr size_t WS_SSPART = 17 * MiB;
constexpr size_t WS_W32T = 20 * MiB;
constexpr size_t WS_XB = 32 * MiB, WS_HB = 32 * MiB;
constexpr size_t WS_PB = 96 * MiB;
constexpr size_t WS_Q = 112 * MiB, WS_K = 144 * MiB, WS_V = 176 * MiB, WS_MIX = 144 * MiB;
constexpr size_t WS_GA = 208 * MiB, WS_GS = 240 * MiB, WS_U = 272 * MiB;
constexpr size_t WS_NUM = 304 * MiB, WS_PROJ = 304 * MiB;
constexpr size_t WS_YG = 400 * MiB, WS_END = 432 * MiB;

constexpr int LDS_BYTES = 163840;

constexpr int MERGE_HIDDEN = 28;
constexpr int LDSCTL_OFF = 163840 - 64;
struct Params { const float* in[20]; float* out; unsigned char* ws; int ph_lo; int ph_hi; int use_cg; int pad; };

__device__ __forceinline__ unsigned f2bf(float f) { unsigned u = __float_as_uint(f); return (u + 0x7fffu + ((u >> 16) & 1u)) >> 16; }
__device__ __forceinline__ float bf2f(unsigned b) { return __uint_as_float(b << 16); }
__device__ __forceinline__ unsigned pk2(float lo, float hi) { return f2bf(lo) | (f2bf(hi) << 16); }
__device__ __forceinline__ float bflo(unsigned w) { return __uint_as_float(w << 16); }
__device__ __forceinline__ float bfhi(unsigned w) { return __uint_as_float(w & 0xffff0000u); }
typedef float f32x2_t __attribute__((ext_vector_type(2))); typedef __bf16 bf16x2_t __attribute__((ext_vector_type(2)));
__device__ __forceinline__ unsigned cvtpk(float lo, float hi) { f32x2_t v = {lo, hi}; bf16x2_t b = __builtin_convertvector(v, bf16x2_t); return __builtin_bit_cast(unsigned, b); }
__device__ __forceinline__ float wave_sum(float v) {
#pragma unroll
    for (int o = 1; o < 64; o <<= 1) v += __shfl_xor(v, o);
    return v;
}
__device__ __forceinline__ float silu_f(float v) { return v * __builtin_amdgcn_rcpf(1.f + __builtin_amdgcn_exp2f(v * -1.4426950408889634f)); }
__device__ __forceinline__ float sigmoid_f(float v) { return __builtin_amdgcn_rcpf(1.f + __builtin_amdgcn_exp2f(v * -1.4426950408889634f)); }
__device__ __forceinline__ int pi_col(int p) { const int t = p >> 8, w = p & 255, bj = w >> 7, wc = (w >> 5) & 3, i = w & 31; return (t << 8) + (wc << 6) + (bj << 5) + i; }

#define LAS __attribute__((address_space(3)))
__device__ __forceinline__ void wg_sync() { __builtin_amdgcn_fence(__ATOMIC_RELEASE, "workgroup"); __builtin_amdgcn_s_barrier(); __builtin_amdgcn_fence(__ATOMIC_ACQUIRE, "workgroup"); }
__device__ __forceinline__ float xsum16(float v) { const auto r = __builtin_amdgcn_permlane16_swap(__float_as_uint(v), __float_as_uint(v), false, false); return __uint_as_float(r[0]) + __uint_as_float(r[1]); }
__device__ __forceinline__ float xsum32(float v) { const auto r = __builtin_amdgcn_permlane32_swap(__float_as_uint(v), __float_as_uint(v), false, false); return __uint_as_float(r[0]) + __uint_as_float(r[1]); }
struct Ctx { int gtid, nthr, gwave, nwaves, lane; };
namespace pg8 {
#define PG8_LAS __attribute__((address_space(3)))
typedef unsigned short bf16_t;
typedef short bf16x8 __attribute__((ext_vector_type(8)));
typedef float f32x4 __attribute__((ext_vector_type(4)));
typedef unsigned u32x4 __attribute__((ext_vector_type(4)));
constexpr int BM = 256, BK = 64, HALF = 128, HTB = HALF * BK * 2  , STAGE_BYTES = 8 * HTB, NXCD = 8, WGM = 8;

__host__ __device__ __forceinline__ int lds_byte(int r, int c) { const int st = (r >> 4) * 2 + (c >> 5), rr = r & 15, cc = c & 31, ob = rr * 64 + cc * 2; return st * 1024 + (ob ^ (((ob >> 9) & 1) << 5)); }
__host__ __device__ __forceinline__ void stage_rc(int b, int& R, int& C) { const int st = b / 1024, sb = b % 1024, swz = sb ^ (((sb >> 9) & 1) << 5); R = (st >> 1) * 16 + swz / 64; C = (st & 1) * 32 + (swz % 64) / 2; }
__host__ __device__ __forceinline__ int perm32(int rho) { const int n = rho >> 4, i = rho & 15; return 8 * (i >> 2) + 4 * n + (i & 3); }

struct Unit { int pm, pn; };
struct Gemm { const bf16_t* A; const bf16_t* Bt; int M, N, K; };

struct StaticOrder {
    int nM, nN, nwg, G, c;
    __host__ __device__ void init(int M, int N, int G_, int c_) { nM = M / BM; nN = N / BM; nwg = nM * nN; G = G_; c = c_; }
    __host__ __device__ bool next(int i, Unit& u) const {
        const long L = (long)i * G + c; if (L >= nwg) return false;
        int wgid = (int)L; { const int q = nwg / NXCD, r = nwg % NXCD, xcd = wgid % NXCD, off = wgid / NXCD; wgid = (xcd < r ? xcd * (q + 1) : r * (q + 1) + (xcd - r) * q) + off; }
        const int nig = WGM * nN, gid = wgid / nig, fm = gid * WGM, gsz = (nM - fm) < WGM ? (nM - fm) : WGM;
        u.pm = fm + ((wgid % nig) % gsz); u.pn = (wgid % nig) / gsz; return true;
    }
    __device__ __forceinline__ void a_ready(const Unit&) const {}
    __device__ __forceinline__ void done(const Unit&) const {}
};

#ifndef EPI_DEPTH
#define EPI_DEPTH 4
#endif
__device__ __forceinline__ u32x4 pack8(const f32x4 a, const f32x4 b) { u32x4 w; w.x = cvtpk(a[0], a[1]); w.y = cvtpk(a[2], a[3]); w.z = cvtpk(b[0], b[1]); w.w = cvtpk(b[2], b[3]); return w; }
__device__ __forceinline__ f32x4 silu4(const f32x4 v) { f32x4 o; o[0] = silu_f(v[0]); o[1] = silu_f(v[1]); o[2] = silu_f(v[2]); o[3] = silu_f(v[3]); return o; }
__device__ __forceinline__ f32x4 sigm4(const f32x4 v) { f32x4 o; o[0] = sigmoid_f(v[0]); o[1] = sigmoid_f(v[1]); o[2] = sigmoid_f(v[2]); o[3] = sigmoid_f(v[3]); return o; }
__device__ __forceinline__ float dot4(const f32x4 a) { return (a[0] * a[0] + a[1] * a[1]) + (a[2] * a[2] + a[3] * a[3]); }
struct EpiInProj {
    static constexpr bool PERM = true, AFTER_DRAIN = false;
    const float* rr; const float* qn; const float* kn; bf16_t *Q, *K, *V, *GA, *GS, *U;
    __device__ __forceinline__ void operator()(const f32x4 (&acc)[2][2][4][2], const Unit& u, int wr, int wc, int fr, int fq) const {
        const int seg = u.pn >> 1, half = u.pn & 1;
        const int row0 = u.pm * BM + wr * 64 + fr;
        const int lc0 = half * 256 + wc * 64 + 8 * fq;
        f32x4 gv[2][2];
#pragma unroll
        for (int bj = 0; bj < 2; ++bj)
#pragma unroll
            for (int n = 0; n < 2; ++n) gv[bj][n] = (f32x4){1.f, 1.f, 1.f, 1.f};
        if (seg < 2) { const float* gp = seg == 0 ? qn : kn; const float sc = seg == 0 ? QSCALE : 1.f;
#pragma unroll
            for (int bj = 0; bj < 2; ++bj)
#pragma unroll
                for (int n = 0; n < 2; ++n) gv[bj][n] = *(const f32x4*)(gp + 32 * bj + 8 * fq + 4 * n) * sc; }
        bf16_t* dst = seg == 0 ? Q : (seg == 1 ? K : (seg == 2 ? V : (seg == 3 ? GA : GS)));
#pragma unroll
        for (int ai = 0; ai < 2; ++ai)
#pragma unroll
            for (int m = 0; m < 4; ++m) {
                const int r = row0 + ai * HALF + m * 16; const float rs = rr[r];
                f32x4 v[2][2];
#pragma unroll
                for (int bj = 0; bj < 2; ++bj)
#pragma unroll
                    for (int n = 0; n < 2; ++n) v[bj][n] = acc[ai][bj][m][n] * rs;
                if (seg < 2) {
                    float ss = (dot4(v[0][0]) + dot4(v[0][1])) + (dot4(v[1][0]) + dot4(v[1][1]));
                    ss = xsum32(xsum16(ss));
                    const float rn = __builtin_amdgcn_rsqf(ss * (1.f / HD) + EPS);
#pragma unroll
                    for (int bj = 0; bj < 2; ++bj)
#pragma unroll
                        for (int n = 0; n < 2; ++n) v[bj][n] = v[bj][n] * rn * gv[bj][n];
                } else if (seg == 3 || seg == 5) {
#pragma unroll
                    for (int bj = 0; bj < 2; ++bj)
#pragma unroll
                        for (int n = 0; n < 2; ++n) v[bj][n] = silu4(v[bj][n]);
                }
#pragma unroll
                for (int bj = 0; bj < 2; ++bj) {
                    const u32x4 w = pack8(v[bj][0], v[bj][1]); const int cc = lc0 + 32 * bj;
                    if (seg == 4) { const int b = r >> 11, s = r & 2047, g = cc >> 4; __builtin_nontemporal_store(w, (u32x4*)(U + ((size_t)(b * NG + g) * SEQ + s) * GC + (cc & 15))); }
                    else if (seg == 3 || seg == 5) __builtin_nontemporal_store(w, (u32x4*)(dst + (size_t)r * AW + cc));
                    else *(u32x4*)(dst + (size_t)r * AW + cc) = w;
                }
            }
    }
};
struct EpiGlu {
    static constexpr bool PERM = true, AFTER_DRAIN = false;
    const float* bglu; const bf16_t* YG; const bf16_t* GS; bf16_t* MIX;
    __device__ __forceinline__ void operator()(const f32x4 (&acc)[2][2][4][2], const Unit& u, int wr, int wc, int fr, int fq) const {
        const int row0 = u.pm * BM + wr * 64 + fr, col0 = u.pn * BM + wc * 32 + 8 * fq;
        f32x4 bv[2][2];
#pragma unroll
        for (int bj = 0; bj < 2; ++bj)
#pragma unroll
            for (int n = 0; n < 2; ++n) bv[bj][n] = *(const f32x4*)(bglu + col0 + bj * HALF + 4 * n);
        u32x4 y8[EPI_DEPTH][2], g8[EPI_DEPTH][2];
#define GLU_ISSUE(g_) do { const int r_ = row0 + ((g_) >> 2) * HALF + ((g_) & 3) * 16; _Pragma("unroll") for (int bj = 0; bj < 2; ++bj) { const int c_ = col0 + bj * HALF; \
            y8[(g_) % EPI_DEPTH][bj] = *(const u32x4*)(YG + (size_t)r_ * AW + c_); g8[(g_) % EPI_DEPTH][bj] = __builtin_nontemporal_load((const u32x4*)(GS + (size_t)r_ * AW + c_)); } } while (0)
#pragma unroll
        for (int g = 0; g < EPI_DEPTH; ++g) GLU_ISSUE(g);
#pragma unroll
        for (int g = 0; g < 8; ++g) { const int ai = g >> 2, m = g & 3, r = row0 + ai * HALF + m * 16;
#pragma unroll
            for (int bj = 0; bj < 2; ++bj) { const int c = col0 + bj * HALF; const u32x4 yv = y8[g % EPI_DEPTH][bj], gv = g8[g % EPI_DEPTH][bj];
                const f32x4 s0 = sigm4(acc[ai][bj][m][0] + bv[bj][0]), s1 = sigm4(acc[ai][bj][m][1] + bv[bj][1]);
                f32x4 o0, o1;
                o0[0] = bflo(yv[0]) * s0[0] * bflo(gv[0]); o0[1] = bfhi(yv[0]) * s0[1] * bfhi(gv[0]); o0[2] = bflo(yv[1]) * s0[2] * bflo(gv[1]); o0[3] = bfhi(yv[1]) * s0[3] * bfhi(gv[1]);
                o1[0] = bflo(yv[2]) * s1[0] * bflo(gv[2]); o1[1] = bfhi(yv[2]) * s1[1] * bfhi(gv[2]); o1[2] = bflo(yv[3]) * s1[2] * bflo(gv[3]); o1[3] = bfhi(yv[3]) * s1[3] * bfhi(gv[3]);
                *(u32x4*)(MIX + (size_t)r * DM + AW + c) = pack8(o0, o1); }
            if (g + EPI_DEPTH < 8) GLU_ISSUE(g + EPI_DEPTH);
            asm volatile("" ::: "memory"); }
#undef GLU_ISSUE
    }
};
struct EpiOut {
    static constexpr bool PERM = true, AFTER_DRAIN = false;
    const bf16_t* xb; bf16_t* HB; float* SSP;
    __device__ __forceinline__ void operator()(const f32x4 (&acc)[2][2][4][2], const Unit& u, int wr, int wc, int fr, int fq) const {
        const int row0 = u.pm * BM + wr * 64 + fr, col0 = u.pn * BM + wc * 32 + 8 * fq;
        u32x4 xv[EPI_DEPTH][2];
#define OUT_ISSUE(g_) do { const int r_ = row0 + ((g_) >> 2) * HALF + ((g_) & 3) * 16; _Pragma("unroll") for (int bj = 0; bj < 2; ++bj) \
            xv[(g_) % EPI_DEPTH][bj] = *(const u32x4*)(xb + (size_t)r_ * DM + col0 + bj * HALF); } while (0)
#pragma unroll
        for (int g = 0; g < EPI_DEPTH; ++g) OUT_ISSUE(g);
#pragma unroll
        for (int g = 0; g < 8; ++g) { const int ai = g >> 2, m = g & 3, r = row0 + ai * HALF + m * 16; float ss = 0.f;
#pragma unroll
            for (int bj = 0; bj < 2; ++bj) { const size_t o = (size_t)r * DM + col0 + bj * HALF; const u32x4 xw = xv[g % EPI_DEPTH][bj];
                const f32x4 h0 = (f32x4){bflo(xw[0]), bfhi(xw[0]), bflo(xw[1]), bfhi(xw[1])} + acc[ai][bj][m][0], h1 = (f32x4){bflo(xw[2]), bfhi(xw[2]), bflo(xw[3]), bfhi(xw[3])} + acc[ai][bj][m][1];
                ss += dot4(h0) + dot4(h1);
                *(u32x4*)(HB + o) = pack8(h0, h1); }
            ss = xsum32(xsum16(ss));
            if (fq == 0) SSP[(size_t)r * 16 + u.pn * 4 + wc] = ss;
            if (g + EPI_DEPTH < 8) OUT_ISSUE(g + EPI_DEPTH);
            asm volatile("" ::: "memory"); }
#undef OUT_ISSUE
    }
};
struct EpiProj {
    static constexpr bool PERM = true, AFTER_DRAIN = false;
    bf16_t* PR;
    __device__ __forceinline__ void operator()(const f32x4 (&acc)[2][2][4][2], const Unit& u, int wr, int wc, int fr, int fq) const {
        const int row0 = u.pm * BM + wr * 64 + fr, col0 = u.pn * BM + wc * 32 + 8 * fq;
#pragma unroll
        for (int ai = 0; ai < 2; ++ai)
#pragma unroll
            for (int m = 0; m < 4; ++m)
#pragma unroll
                for (int bj = 0; bj < 2; ++bj) *(u32x4*)(PR + (size_t)(row0 + ai * HALF + m * 16) * DM + col0 + bj * HALF) = pack8(acc[ai][bj][m][0], acc[ai][bj][m][1]);
    }
};
struct EpiGate {
    static constexpr bool PERM = true, AFTER_DRAIN = false;
    const float* RRH; const bf16_t* PR; const bf16_t* HBr; float* out;
    __device__ __forceinline__ void operator()(const f32x4 (&acc)[2][2][4][2], const Unit& u, int wr, int wc, int fr, int fq) const {
        const int row0 = u.pm * BM + wr * 64 + fr, col0 = u.pn * BM + wc * 32 + 8 * fq;
        float rsv[8];
#pragma unroll
        for (int g = 0; g < 8; ++g) rsv[g] = RRH[row0 + (g >> 2) * HALF + (g & 3) * 16];
        u32x4 p8[EPI_DEPTH][2], h8[EPI_DEPTH][2];
#define GATE_ISSUE(g_) do { const int r_ = row0 + ((g_) >> 2) * HALF + ((g_) & 3) * 16; _Pragma("unroll") for (int bj = 0; bj < 2; ++bj) { const size_t o_ = (size_t)r_ * DM + col0 + bj * HALF; \
            p8[(g_) % EPI_DEPTH][bj] = *(const u32x4*)(PR + o_); h8[(g_) % EPI_DEPTH][bj] = *(const u32x4*)(HBr + o_); } } while (0)
#pragma unroll
        for (int g = 0; g < EPI_DEPTH; ++g) GATE_ISSUE(g);
#pragma unroll
        for (int g = 0; g < 8; ++g) { const int ai = g >> 2, m = g & 3, r = row0 + ai * HALF + m * 16; const float rs = rsv[g];
#pragma unroll
            for (int bj = 0; bj < 2; ++bj) { const size_t o = (size_t)r * DM + col0 + bj * HALF; const u32x4 pv = p8[g % EPI_DEPTH][bj], hv = h8[g % EPI_DEPTH][bj];
                const f32x4 g0 = sigm4(acc[ai][bj][m][0] * rs), g1 = sigm4(acc[ai][bj][m][1] * rs);
                f32x4 o0, o1;
                o0[0] = bflo(hv[0]) + g0[0] * bflo(pv[0]); o0[1] = bfhi(hv[0]) + g0[1] * bfhi(pv[0]); o0[2] = bflo(hv[1]) + g0[2] * bflo(pv[1]); o0[3] = bfhi(hv[1]) + g0[3] * bfhi(pv[1]);
                o1[0] = bflo(hv[2]) + g1[0] * bflo(pv[2]); o1[1] = bfhi(hv[2]) + g1[1] * bfhi(pv[2]); o1[2] = bflo(hv[3]) + g1[2] * bflo(pv[3]); o1[3] = bfhi(hv[3]) + g1[3] * bfhi(pv[3]);
                __builtin_nontemporal_store(o0, (f32x4*)(out + o)); __builtin_nontemporal_store(o1, (f32x4*)(out + o + 4)); }
            if (g + EPI_DEPTH < 8) GATE_ISSUE(g + EPI_DEPTH);
            asm volatile("" ::: "memory"); }
#undef GATE_ISSUE
    }
};
template <class Epi, class Sched, bool ALIGN_EPI = false, bool SP2 = false>
__device__ __forceinline__ void gemm_phase(PG8_LAS unsigned char* lds, const Gemm g, const Sched& S, const Epi& E) {
    const int tid = threadIdx.x, wid = __builtin_amdgcn_readfirstlane(tid >> 6), lane = tid & 63, wr = wid >> 2, wc = wid & 3, fr = lane & 15, fq = lane >> 4;
    const int K = g.K, nt = K / BK;
    unsigned voffA[2], voffB[2];
#pragma unroll
    for (int i = 0; i < 2; ++i) { int R, C; stage_rc(tid * 16 + i * 8192, R, C); const int Rb = Epi::PERM ? ((R & ~31) + perm32(R & 31)) : R;
        voffA[i] = (unsigned)(R * K + C) * 2u; voffB[i] = (unsigned)(Rb * K + C) * 2u; }
    const size_t kstep = (size_t)(BK * 2);
    const size_t hstep = (size_t)HALF * K * 2;
    const size_t tstep = 2 * hstep;
    const unsigned ldsw = (unsigned)wid * 1024u;
    const int aoff = lds_byte(wr * 64 + fr, fq * 8), boff = lds_byte(wc * 32 + fr, fq * 8);
#define PG8_SA(b, h) (((b) * 2 + (h)) * HTB)
#define PG8_SB(b, h) ((4 + (b) * 2 + (h)) * HTB)
#define PG8_STAGE(bufoff, gbase, voff) do { _Pragma("unroll") for (int _i = 0; _i < 2; ++_i) \
        __builtin_amdgcn_global_load_lds((const unsigned*)((const char*)(gbase) + (voff)[_i]), (PG8_LAS unsigned*)(lds + (bufoff) + ldsw + _i * 8192), 16, 0, 0); } while (0)
#define PG8_LDA(dst, b, h) do { _Pragma("unroll") for (int m = 0; m < 4; ++m) _Pragma("unroll") for (int k = 0; k < 2; ++k) dst[m][k] = *(const PG8_LAS bf16x8*)(lds + PG8_SA(b, h) + aoff + m * 2048 + k * 1024); } while (0)
#define PG8_LDB(dst, b, h) do { _Pragma("unroll") for (int n = 0; n < 2; ++n) _Pragma("unroll") for (int k = 0; k < 2; ++k) dst[n][k] = *(const PG8_LAS bf16x8*)(lds + PG8_SB(b, h) + boff + n * 2048 + k * 1024); } while (0)
#define PG8_MMA(ai, bj, At, Bt) do { __builtin_amdgcn_s_setprio(1); _Pragma("unroll") for (int m = 0; m < 4; ++m) _Pragma("unroll") for (int n = 0; n < 2; ++n) _Pragma("unroll") for (int k = 0; k < 2; ++k) \
        acc[ai][bj][m][n] = __builtin_amdgcn_mfma_f32_16x16x32_bf16(Bt[n][k], At[m][k], acc[ai][bj][m][n], 0, 0, 0); __builtin_amdgcn_s_setprio(0); } while (0)
#define PG8_WAIT_V(n) asm volatile("s_waitcnt vmcnt(" #n ")" ::: "memory")
#define PG8_WAIT_L(n) asm volatile("s_waitcnt lgkmcnt(" #n ")" ::: "memory")
#define PG8_BAR __builtin_amdgcn_s_barrier()
#define PG8_SCHED __builtin_amdgcn_sched_barrier(0)
    Unit cur, nxt; int ui = 0;
    if (!S.next(0, cur)) return;
    f32x4 acc[2][2][4][2];
#pragma unroll
    for (int a = 0; a < 2; ++a)
#pragma unroll
        for (int b = 0; b < 2; ++b)
#pragma unroll
            for (int m = 0; m < 4; ++m)
#pragma unroll
                for (int n = 0; n < 2; ++n) acc[a][b][m][n] = (f32x4){0.f, 0.f, 0.f, 0.f};
    bf16x8 At[4][2], B0[2][2], B1[2][2];
    const char* cA = (const char*)g.A + (size_t)cur.pm * tstep; const char* cB = (const char*)g.Bt + (size_t)cur.pn * tstep;
    S.a_ready(cur);
    if constexpr (SP2) {
        PG8_STAGE(PG8_SB(0, 0), cB, voffB); PG8_STAGE(PG8_SB(0, 1), cB + hstep, voffB); PG8_STAGE(PG8_SA(0, 0), cA, voffA); PG8_STAGE(PG8_SA(0, 1), cA + hstep, voffA);
        if (wr == 1) PG8_BAR;
        PG8_WAIT_V(2); PG8_BAR;
        PG8_STAGE(PG8_SB(1, 0), cB + kstep, voffB); PG8_STAGE(PG8_SA(1, 0), cA + kstep, voffA); PG8_STAGE(PG8_SB(1, 1), cB + hstep + kstep, voffB);
        PG8_WAIT_V(6); PG8_BAR;
    } else {
        PG8_STAGE(PG8_SB(0, 0), cB, voffB); PG8_STAGE(PG8_SA(0, 0), cA, voffA); PG8_STAGE(PG8_SB(0, 1), cB + hstep, voffB); PG8_STAGE(PG8_SA(0, 1), cA + hstep, voffA);
        if (wr == 1) PG8_BAR;
        PG8_WAIT_V(4); PG8_BAR;
        PG8_STAGE(PG8_SB(1, 0), cB + kstep, voffB); PG8_STAGE(PG8_SA(1, 0), cA + kstep, voffA); PG8_STAGE(PG8_SB(1, 1), cB + hstep + kstep, voffB);
        PG8_WAIT_V(6); PG8_BAR;
    }
    for (;;) {
        const bool has_next = S.next(ui + 1, nxt);
        const char* nA = has_next ? (const char*)g.A + (size_t)nxt.pm * tstep : cA; const char* nB = has_next ? (const char*)g.Bt + (size_t)nxt.pn * tstep : cB;
#pragma nounroll
        for (int t = 0; t < nt; t += 2) {
            const bool last = (t == nt - 2);
            const char* a1 = cA + (size_t)(t + 1) * kstep;
            const char* a2 = last ? nA : cA + (size_t)(t + 2) * kstep; const char* b2 = last ? nB : cB + (size_t)(t + 2) * kstep;
            const char* a3 = a2 + kstep; const char* b3 = b2 + kstep;
            if (last && has_next) S.a_ready(nxt);
            if constexpr (SP2) {
            PG8_LDB(B0, 0, 0); PG8_LDB(B1, 0, 1); PG8_SCHED; PG8_LDA(At, 0, 0); PG8_STAGE(PG8_SA(1, 1), a1 + hstep, voffA);
            PG8_WAIT_V(8); PG8_WAIT_L(0); PG8_BAR; PG8_MMA(0, 0, At, B0); PG8_MMA(0, 1, At, B1); PG8_BAR; PG8_SCHED;
            PG8_LDA(At, 0, 1); PG8_STAGE(PG8_SB(0, 0), b2, voffB); PG8_STAGE(PG8_SB(0, 1), b2 + hstep, voffB); PG8_STAGE(PG8_SA(0, 0), a2, voffA);
            PG8_WAIT_V(8); PG8_WAIT_L(0); PG8_BAR; PG8_MMA(1, 0, At, B0); PG8_MMA(1, 1, At, B1); PG8_BAR; PG8_SCHED;
            PG8_LDB(B0, 1, 0); PG8_LDB(B1, 1, 1); PG8_SCHED; PG8_LDA(At, 1, 0); PG8_STAGE(PG8_SA(0, 1), a2 + hstep, voffA);
            PG8_WAIT_V(8); PG8_WAIT_L(0); PG8_BAR; PG8_MMA(0, 0, At, B0); PG8_MMA(0, 1, At, B1); PG8_BAR; PG8_SCHED;
            PG8_LDA(At, 1, 1); PG8_STAGE(PG8_SB(1, 0), b3, voffB); PG8_STAGE(PG8_SB(1, 1), b3 + hstep, voffB); PG8_STAGE(PG8_SA(1, 0), a3, voffA);
            PG8_WAIT_V(8); PG8_WAIT_L(0); PG8_BAR; PG8_MMA(1, 0, At, B0); PG8_MMA(1, 1, At, B1); PG8_BAR; PG8_SCHED;
            } else {
            PG8_LDB(B0, 0, 0); PG8_SCHED; PG8_LDA(At, 0, 0); PG8_STAGE(PG8_SA(1, 1), a1 + hstep, voffA);
            PG8_WAIT_L(8); PG8_BAR; PG8_WAIT_L(0); PG8_MMA(0, 0, At, B0); PG8_BAR; PG8_SCHED;
            PG8_LDB(B1, 0, 1); PG8_STAGE(PG8_SB(0, 0), b2, voffB);
            PG8_BAR; PG8_WAIT_L(0); PG8_MMA(0, 1, At, B1); PG8_BAR;
            PG8_LDA(At, 0, 1); PG8_STAGE(PG8_SA(0, 0), a2, voffA);
            PG8_BAR; PG8_WAIT_L(0); PG8_MMA(1, 0, At, B0); PG8_BAR; PG8_SCHED;
            PG8_STAGE(PG8_SB(0, 1), b2 + hstep, voffB);
            PG8_WAIT_V(6); PG8_BAR; PG8_MMA(1, 1, At, B1); PG8_BAR;
            PG8_LDB(B0, 1, 0); PG8_SCHED; PG8_LDA(At, 1, 0); PG8_STAGE(PG8_SA(0, 1), a2 + hstep, voffA);
            PG8_WAIT_L(8); PG8_BAR; PG8_WAIT_L(0); PG8_MMA(0, 0, At, B0); PG8_BAR; PG8_SCHED;
            PG8_LDB(B1, 1, 1); PG8_STAGE(PG8_SB(1, 0), b3, voffB);
            PG8_BAR; PG8_WAIT_L(0); PG8_MMA(0, 1, At, B1); PG8_BAR;
            PG8_LDA(At, 1, 1); PG8_STAGE(PG8_SA(1, 0), a3, voffA);
            PG8_BAR; PG8_WAIT_L(0); PG8_MMA(1, 0, At, B0); PG8_BAR; PG8_SCHED;
            PG8_STAGE(PG8_SB(1, 1), b3 + hstep, voffB);
            PG8_WAIT_V(6); PG8_BAR; PG8_MMA(1, 1, At, B1); PG8_BAR;
            }
        }
        if constexpr (ALIGN_EPI) { if (wr == 0) PG8_BAR; }
        if constexpr (!Epi::AFTER_DRAIN) { E(acc, cur, wr, wc, fr, fq); S.done(cur); }
        if (!has_next) break;
#pragma unroll
        for (int a = 0; a < 2; ++a)
#pragma unroll
            for (int b = 0; b < 2; ++b)
#pragma unroll
                for (int m = 0; m < 4; ++m)
#pragma unroll
                    for (int n = 0; n < 2; ++n) acc[a][b][m][n] = (f32x4){0.f, 0.f, 0.f, 0.f};
        cur = nxt; cA = nA; cB = nB; ++ui;
        if constexpr (ALIGN_EPI) { if (wr == 1) PG8_BAR; }
    }
    PG8_WAIT_V(0);
    if constexpr (!ALIGN_EPI) { if (wr == 0) PG8_BAR; }
    PG8_BAR;
    if constexpr (Epi::AFTER_DRAIN) { E.fused(acc, cur, wr, wc, fr, fq, lds, wid, lane); S.done(cur); }
#undef PG8_SA
#undef PG8_SB
#undef PG8_STAGE
#undef PG8_LDA
#undef PG8_LDB
#undef PG8_MMA
#undef PG8_WAIT_V
#undef PG8_WAIT_L
#undef PG8_BAR
#undef PG8_SCHED
}
}
template <bool PERMCOL>
__device__ __forceinline__ void transpose_item(const float* W, int K, int N, bf16_t* WT, const float* ksc, LAS float* scr, int item, int lane) {
    const int nblk = N / 32, kb = item / nblk, nb = item % nblk, k0 = 64 * kb, n0 = 32 * nb;
    const int src0 = PERMCOL ? pi_col(n0) : n0;
    float tv[32];
#pragma unroll
    for (int i = 0; i < 32; ++i) { const int kk = 2 * i + (lane >> 5); tv[i] = __builtin_nontemporal_load(W + (size_t)(k0 + kk) * N + src0 + (lane & 31)); }
#pragma unroll
    for (int i = 0; i < 32; ++i) { const int kk = 2 * i + (lane >> 5); scr[kk * 33 + (lane & 31)] = tv[i] * (ksc ? ksc[k0 + kk] : 1.f); }
    asm volatile("s_waitcnt lgkmcnt(0)" ::: "memory");
    const int c8 = lane & 7;
#pragma unroll
    for (int j = 0; j < 4; ++j) { const int n = (lane >> 3) + 8 * j; const LAS float* s = scr + (8 * c8) * 33 + n;
        u32x4 o; o.x = cvtpk(s[0 * 33], s[1 * 33]); o.y = cvtpk(s[2 * 33], s[3 * 33]); o.z = cvtpk(s[4 * 33], s[5 * 33]); o.w = cvtpk(s[6 * 33], s[7 * 33]);
        *(u32x4*)(WT + (size_t)(n0 + n) * K + k0 + 8 * c8) = o; }
    asm volatile("s_waitcnt lgkmcnt(0)" ::: "memory");
}
__device__ __forceinline__ void ph_prep(const Params& P, const Ctx& c, LAS unsigned char* lds) {
    unsigned char* ws = P.ws;
    LAS float* scr = (LAS float*)(lds + (threadIdx.x >> 6) * 8704);
    constexpr int I_IN = (DM / 64) * (INW / 32);
    for (int it = c.gwave; it < I_IN; it += c.nwaves) transpose_item<true>(P.in[3], DM, INW, (bf16_t*)(ws + WS_WINT), P.in[2], scr, it, c.lane);
    const float* x = P.in[0]; bf16_t* XB = (bf16_t*)(ws + WS_XB); float* rr = (float*)(ws + WS_RRMSX);
    const bool stag = gridDim.x == 256;
    for (int idx0 = c.gwave * 8; idx0 < (stag ? T / 2 : T); idx0 += c.nwaves * 8) {
        const int row0 = stag ? ((((idx0 >> 11) * 16 + ((idx0 >> 8) & 7)) << 8) + (idx0 & 255)) : idx0;
        f32x4 v[8][4];
#pragma unroll
        for (int q = 0; q < 8; ++q) { const f32x4* xr = (const f32x4*)(x + (size_t)(row0 + q) * DM) + c.lane;
#pragma unroll
            for (int j = 0; j < 4; ++j) v[q][j] = __builtin_nontemporal_load(xr + 64 * j); }
#pragma unroll
        for (int q = 0; q < 8; ++q) {
            float s = 0.f;
#pragma unroll
            for (int j = 0; j < 4; ++j) s += (v[q][j].x * v[q][j].x + v[q][j].y * v[q][j].y) + (v[q][j].z * v[q][j].z + v[q][j].w * v[q][j].w);
            s = wave_sum(s);
            if (c.lane == 0) rr[row0 + q] = 1.0f / sqrtf(s * (1.f / DM) + EPS);
            unsigned long long* o8 = (unsigned long long*)(XB + (size_t)(row0 + q) * DM) + c.lane;
#pragma unroll
            for (int j = 0; j < 4; ++j) o8[64 * j] = (unsigned long long)cvtpk(v[q][j].x, v[q][j].y) | ((unsigned long long)cvtpk(v[q][j].z, v[q][j].w) << 32);
        }
    }
}
__device__ __forceinline__ void st8_wt(void* p, unsigned long long v) { asm volatile("global_store_dwordx2 %0, %1, off sc0 sc1" :: "v"(p), "v"(v) : "memory"); }
__device__ __forceinline__ void st4_wt(void* p, float v) { asm volatile("global_store_dword %0, %1, off sc0 sc1" :: "v"(p), "v"(v) : "memory"); }
__device__ __forceinline__ void convert_rows_wt(const float* __restrict__ x, bf16_t* XB, float* rr, int row0, int lane) {
#pragma unroll 1
    for (int h = 0; h < 2; ++h) {
        f32x4 v[4][4];
#pragma unroll
        for (int q = 0; q < 4; ++q) { const f32x4* xr = (const f32x4*)(x + (size_t)(row0 + 4 * h + q) * DM) + lane;
#pragma unroll
            for (int j = 0; j < 4; ++j) v[q][j] = __builtin_nontemporal_load(xr + 64 * j); }
#pragma unroll
        for (int q = 0; q < 4; ++q) {
            float s = 0.f;
#pragma unroll
            for (int j = 0; j < 4; ++j) s += (v[q][j].x * v[q][j].x + v[q][j].y * v[q][j].y) + (v[q][j].z * v[q][j].z + v[q][j].w * v[q][j].w);
            s = wave_sum(s);
            if (lane == 0) st4_wt(rr + row0 + 4 * h + q, 1.0f / sqrtf(s * (1.f / DM) + EPS));
            unsigned long long* o8 = (unsigned long long*)(XB + (size_t)(row0 + 4 * h + q) * DM) + lane;
#pragma unroll
            for (int j = 0; j < 4; ++j) st8_wt(o8 + 64 * j, (unsigned long long)cvtpk(v[q][j].x, v[q][j].y) | ((unsigned long long)cvtpk(v[q][j].z, v[q][j].w) << 32));
        }
    }
    asm volatile("s_waitcnt vmcnt(0)" ::: "memory");
}
__device__ __forceinline__ void ph_prep_late(const Params& P, const Ctx& c, LAS unsigned char* lds, const int part) {
    unsigned char* ws = P.ws;
    LAS float* scr = (LAS float*)(lds + (threadIdx.x >> 6) * 8704);
    constexpr int I_GLU = (AW / 64) * (AW / 32), I_SQ = (DM / 64) * (DM / 32), I_P = (PLE / 64) * (DM / 32);
    const int lo_it = part == 0 ? 0 : 2 * I_SQ, hi_it = part == 0 ? 2 * I_SQ : I_GLU + 2 * I_SQ + I_P;
    for (int it = lo_it + c.gwave; it < hi_it; it += c.nwaves) {
        int r = it;
        if (r < I_SQ) { transpose_item<false>(P.in[16], DM, DM, (bf16_t*)(ws + WS_WOUTT), nullptr, scr, r, c.lane); continue; } r -= I_SQ;
        if (r < I_SQ) { transpose_item<false>(P.in[18], DM, DM, (bf16_t*)(ws + WS_WGT), P.in[17], scr, r, c.lane); continue; } r -= I_SQ;
        if (r < I_GLU) { transpose_item<false>(P.in[14], AW, AW, (bf16_t*)(ws + WS_WGLUT), nullptr, scr, r, c.lane); continue; } r -= I_GLU;
        transpose_item<false>(P.in[19], PLE, DM, (bf16_t*)(ws + WS_WPT), nullptr, scr, r, c.lane);
    }
}
__device__ __forceinline__ void ph_prep_p(const Params& P, const Ctx& c) {
    unsigned char* ws = P.ws;
    const float* p = P.in[1]; bf16_t* PB = (bf16_t*)(ws + WS_PB);
    constexpr size_t NV = (size_t)T * PLE / 4;
    for (size_t i = c.gtid; i < NV / 16; i += c.nthr) {
        f32x4 v[16];
#pragma unroll
        for (int q = 0; q < 16; ++q) v[q] = __builtin_nontemporal_load((const f32x4*)p + i + (size_t)q * (NV / 16));
#pragma unroll
        for (int q = 0; q < 16; ++q) ((unsigned long long*)PB)[i + (size_t)q * (NV / 16)] = (unsigned long long)cvtpk(v[q].x, v[q].y) | ((unsigned long long)cvtpk(v[q].z, v[q].w) << 32);
    }
}
__device__ __forceinline__ void ph_attn_naive(const Params& P, const Ctx& c) {
    unsigned char* ws = P.ws;
    const bf16_t* Q = (const bf16_t*)(ws + WS_Q); const bf16_t* K = (const bf16_t*)(ws + WS_K); const bf16_t* V = (const bf16_t*)(ws + WS_V);
    bf16_t* NUM = (bf16_t*)(ws + WS_NUM); float* DEN = (float*)(ws + WS_DEN);
    for (int it = c.gwave; it < 3 * T * NH; it += c.nwaves) {
        const int h = it & 7, rc = it >> 3, row = rc % T, cf = rc / T;
        const int dil = cf == 0 ? 1 : (cf == 1 ? 4 : 16);
        const int s = row & 2047; const size_t rb = (size_t)(row - s);
        const float q = bf2f(Q[(size_t)row * AW + h * HD + c.lane]);
        float acc = 0.f, den = 0.f;
        for (int j = 0; j <= 128; ++j) {
            const int ks = s - j * dil; if (ks < 0) break;
            const size_t off = (rb + ks) * AW + h * HD + c.lane;
            const float sc = wave_sum(q * bf2f(K[off]));
            const float p = exp2f(sc); den += p; acc += p * bf2f(V[off]);
        }
        NUM[((size_t)cf * T + row) * AW + h * HD + c.lane] = (bf16_t)f2bf(acc);
        if (c.lane == 0) DEN[((size_t)cf * T + row) * NH + h] = den;
    }
}
__device__ __forceinline__ void ph_ssm_naive(const Params& P, const Ctx& c) {
    unsigned char* ws = P.ws;
    const float* lam_re = P.in[6]; const float* lam_im = P.in[7]; const float* log_dt = P.in[8];
    const float* b_re = P.in[9]; const float* b_im = P.in[10]; const float* c_re = P.in[11]; const float* c_im = P.in[12]; const float* d_skip = P.in[13];
    const bf16_t* U = (const bf16_t*)(ws + WS_U); bf16_t* YG = (bf16_t*)(ws + WS_YG);
    for (int it = c.gwave; it < NB * NG; it += c.nwaves) {
        const int b = it / NG, g = it % NG, n = c.lane;
        const float dt = expf(log_dt[g]), lr = lam_re[g * NS + n], li = lam_im[g * NS + n];
        const float mag = expf(lr * dt); float sn, cs; sincosf(li * dt, &sn, &cs);
        const float ar = mag * cs, ai = mag * sn;
        const float dn = lr * lr + li * li, nr = ar - 1.f;
        const float cr = (nr * lr + ai * li) / dn, ci = (ai * lr - nr * li) / dn;
        float bbr[16], bbi[16], cre[16], cim[16];
#pragma unroll
        for (int ch = 0; ch < 16; ++ch) { const float br = b_re[(size_t)(g * NS + n) * GC + ch], bi = b_im[(size_t)(g * NS + n) * GC + ch];
            bbr[ch] = cr * br - ci * bi; bbi[ch] = cr * bi + ci * br; cre[ch] = c_re[(size_t)(g * GC + ch) * NS + n]; cim[ch] = c_im[(size_t)(g * GC + ch) * NS + n]; }
        const float dsk = d_skip[g * GC + (c.lane & 15)];
        float xr = 0.f, xi = 0.f;
        const bf16_t* up = U + (size_t)(b * NG + g) * SEQ * GC;
        for (int s = 0; s < SEQ; ++s) {
            const u32x4 w0 = *(const u32x4*)(up + (size_t)s * GC), w1 = *(const u32x4*)(up + (size_t)s * GC + 8);
            float uu[16];
#pragma unroll
            for (int j = 0; j < 4; ++j) { uu[2 * j] = bflo(w0[j]); uu[2 * j + 1] = bfhi(w0[j]); uu[8 + 2 * j] = bflo(w1[j]); uu[8 + 2 * j + 1] = bfhi(w1[j]); }
            float bur = 0.f, bui = 0.f;
#pragma unroll
            for (int ch = 0; ch < 16; ++ch) { bur += uu[ch] * bbr[ch]; bui += uu[ch] * bbi[ch]; }
            const float nxr = ar * xr - ai * xi + bur, nxi = ar * xi + ai * xr + bui; xr = nxr; xi = nxi;
            float myy = 0.f, myu = 0.f;
#pragma unroll
            for (int ch = 0; ch < 16; ++ch) { const float tsum = wave_sum(xr * cre[ch] - xi * cim[ch]); if (c.lane == ch) { myy = tsum; myu = uu[ch]; } }
            if (c.lane < 16) { const float y = myy + dsk * myu; const float yg = 0.5f * y * (1.f + erff(y * 0.70710678118654752f));
                YG[(size_t)(b * SEQ + s) * AW + g * GC + c.lane] = (bf16_t)f2bf(yg); }
        }
    }
}
typedef short v4i16_t __attribute__((ext_vector_type(4)));
typedef float f32x16 __attribute__((ext_vector_type(16)));
namespace att {
constexpr int KSTR = 144;
constexpr int NROW = 384, LDS_V = NROW * KSTR, LDS_O = 2 * NROW * KSTR, NUNIT = NB * NH * 24;
struct Desc { int cfg, b, h, cls, jb; };
struct Stage { u32x4 k[6], v[6]; bf16x8 q[4]; };
__device__ __forceinline__ Desc decode(int n) {
    Desc d; d.h = n & 7; const int u = n >> 3, loc = u % 24, idx = loc & 7; d.b = u / 24; d.cfg = loc >> 3;
    d.cls = d.cfg == 0 ? 0 : (d.cfg == 1 ? (idx >> 1) : 2 * idx); d.jb = d.cfg == 0 ? idx : (d.cfg == 1 ? (idx & 1) : 0); return d;
}
__device__ __forceinline__ v4i16_t vtr(LAS const unsigned char* p) { return __builtin_amdgcn_ds_read_tr16_b64_v4i16((LAS v4i16_t*)p); }
__device__ __forceinline__ int strip_of(const Desc& d, int w) { return (d.cfg == 2 && w >= 4) ? 11 - w : w; }
__device__ __forceinline__ int first_tile(const Desc& d, int s) { return d.cfg == 2 ? 4 - (s & 3) : (d.jb == 0 && s < 4 ? 4 - s : 0); }
__device__ __forceinline__ size_t qrow_of(const Desc& d, int s, int ql) {
    const int cls = d.cfg == 2 ? d.cls + (s >> 2) : d.cls, pos = d.cfg == 2 ? 32 * (s & 3) + ql : 256 * d.jb + 32 * s + ql;
    return (size_t)d.b * SEQ + (size_t)pos * (1 << (2 * d.cfg)) + cls;
}
__device__ __forceinline__ void stage_load(Stage& S, const Desc& d, const bf16_t* __restrict__ Q, const bf16_t* __restrict__ K, const bf16_t* __restrict__ V, int tid, int w, int lane) {
    const int dil = 1 << (2 * d.cfg); const size_t rowb = (size_t)d.b * SEQ;
#pragma unroll
    for (int it = 0; it < 6; ++it) {
        const int idx = tid + it * 512, key = idx >> 3, ch = idx & 7;
        const bool valid = it >= 2 || (d.cfg != 2 && d.jb > 0);
        const int cls = d.cls + ((d.cfg == 2 && it >= 4) ? 1 : 0), pos = d.cfg == 2 ? (key & 127) : 256 * d.jb - 128 + key;
        S.k[it] = (u32x4){0u, 0u, 0u, 0u}; S.v[it] = (u32x4){0u, 0u, 0u, 0u};
        if (valid) { const size_t off = (rowb + (size_t)pos * dil + cls) * AW + d.h * HD + ch * 8; S.k[it] = *(const u32x4*)(K + off); S.v[it] = *(const u32x4*)(V + off); }
    }
    const size_t qrow = qrow_of(d, strip_of(d, w), lane & 31);
#pragma unroll
    for (int ks = 0; ks < 4; ++ks) S.q[ks] = *(const bf16x8*)(Q + qrow * AW + d.h * HD + 16 * ks + 8 * (lane >> 5));
}
__device__ __forceinline__ void stage_write(const Stage& S, LAS unsigned char* buf, int tid) {
#pragma unroll
    for (int it = 0; it < 6; ++it) { const int idx = tid + it * 512, key = idx >> 3, ch = idx & 7;
        *(LAS u32x4*)(buf + key * KSTR + ch * 16) = S.k[it]; *(LAS u32x4*)(buf + LDS_V + key * KSTR + ch * 16) = S.v[it]; }
}
#define ATT_A(t_) { f32x16 a_; _Pragma("unroll") for (int r = 0; r < 16; ++r) a_[r] = 0.f; \
    _Pragma("unroll") for (int ks = 0; ks < 4; ++ks) { const bf16x8 kf = *(LAS const bf16x8*)(kb + 32 * (t_) * KSTR + 32 * ks); a_ = __builtin_amdgcn_mfma_f32_32x32x16_bf16(kf, qf[ks], a_, 0, 0, 0); } \
    sc[t_] = a_; }
#define ATT_B(t_) { _Pragma("unroll") for (int r = 0; r < 16; r += 2) { \
        const int kl = (r & 3) + 8 * (r >> 2) + 4 * half; bool v0 = true, v1 = true; \
        if ((t_) == 0) { v0 = kl >= ql; v1 = kl + 1 >= ql; } if ((t_) == 4) { v0 = kl <= ql; v1 = kl + 1 <= ql; } \
        f32x2_t p2; p2.x = v0 ? __builtin_amdgcn_exp2f(sc[t_][r]) : 0.f; p2.y = v1 ? __builtin_amdgcn_exp2f(sc[t_][r + 1]) : 0.f; \
        den2 += p2; pk[t_][r >> 3][(r >> 1) & 3] = cvtpk(p2.x, p2.y); } }
#define ATT_C(t_) { _Pragma("unroll") for (int k2 = 0; k2 < 2; ++k2) { const bf16x8 pf = __builtin_bit_cast(bf16x8, pk[t_][k2]); \
        _Pragma("unroll") for (int db = 0; db < 2; ++db) { \
            const v4i16_t lo = vtr(vb + (32 * (t_) + 16 * k2) * KSTR + 64 * db), hi = vtr(vb + (32 * (t_) + 16 * k2 + 8) * KSTR + 64 * db); \
            const bf16x8 vf = (bf16x8){lo[0], lo[1], lo[2], lo[3], hi[0], hi[1], hi[2], hi[3]}; \
            o[db] = __builtin_amdgcn_mfma_f32_32x32x16_bf16(vf, pf, o[db], 0, 0, 0); } } }
template <int T0>
__device__ __forceinline__ void compute_t(const Desc& d, const bf16x8 (&qf)[4], LAS const unsigned char* buf, bf16_t* NUM, float* DEN, int s, int w, int lane) {
    const int ql = lane & 31, half = lane >> 5, i16 = lane & 15, dh = (lane >> 4) & 1;
    LAS const unsigned char* kb = buf + (32 * s + ql) * KSTR + 16 * half;
    LAS const unsigned char* vb = buf + LDS_V + (32 * s + 4 * half + (i16 >> 2)) * KSTR + 8 * (i16 & 3) + 32 * dh;
    f32x16 sc[5]; u32x4 pk[5][2]; f32x2_t den2 = (f32x2_t){0.f, 0.f}; f32x16 o[2];
#pragma unroll
    for (int db = 0; db < 2; ++db)
#pragma unroll
        for (int r = 0; r < 16; ++r) o[db][r] = 0.f;
    ATT_A(T0)
    if (T0 + 1 <= 4) ATT_A(T0 + 1 <= 4 ? T0 + 1 : 4)
    ATT_B(T0)
    __builtin_amdgcn_sched_barrier(0);
#pragma unroll
    for (int k = T0 + 1; k <= 4; ++k) {
        if (k + 1 <= 4) ATT_A(k + 1 <= 4 ? k + 1 : 4)
        ATT_C(k - 1)
        ATT_B(k)
        __builtin_amdgcn_sched_barrier(0);
    }
    ATT_C(4)
    const float den = xsum32(den2.x + den2.y);
    LAS unsigned char* ob = (LAS unsigned char*)buf + LDS_O + w * (32 * KSTR);
#pragma unroll
    for (int db = 0; db < 2; ++db)
#pragma unroll
        for (int rg = 0; rg < 4; ++rg) {
            const unsigned long long v = (unsigned long long)cvtpk(o[db][4 * rg], o[db][4 * rg + 1]) | ((unsigned long long)cvtpk(o[db][4 * rg + 2], o[db][4 * rg + 3]) << 32);
            *(LAS unsigned long long*)(ob + ql * KSTR + 64 * db + 16 * rg + 8 * half) = v;
        }
#pragma unroll
    for (int i = 0; i < 4; ++i) {
        const int qr = (lane >> 3) + 8 * i; const u32x4 v = *(LAS const u32x4*)(ob + qr * KSTR + 16 * (lane & 7));
        *(u32x4*)(NUM + ((size_t)d.cfg * T + qrow_of(d, s, qr)) * AW + d.h * HD + 8 * (lane & 7)) = v;
    }
    const size_t qrow = qrow_of(d, s, ql);
    if (half == 0) DEN[((size_t)d.cfg * T + qrow) * NH + d.h] = den;
}
__device__ __forceinline__ void compute(const Desc& d, const bf16x8 (&qf)[4], LAS const unsigned char* buf, bf16_t* NUM, float* DEN, int w, int lane) {
    const int s = strip_of(d, w), t0 = first_tile(d, s);
    switch (t0) {
        case 0: compute_t<0>(d, qf, buf, NUM, DEN, s, w, lane); break;
        case 1: compute_t<1>(d, qf, buf, NUM, DEN, s, w, lane); break;
        case 2: compute_t<2>(d, qf, buf, NUM, DEN, s, w, lane); break;
        case 3: compute_t<3>(d, qf, buf, NUM, DEN, s, w, lane); break;
        default: compute_t<4>(d, qf, buf, NUM, DEN, s, w, lane); break;
    }
}
}
#define ATT_BAR() asm volatile("s_waitcnt lgkmcnt(0)\n\ts_barrier" ::: "memory")
__device__ __forceinline__ void ph_attn(const Params& P, LAS unsigned char* lds) {
    unsigned char* ws = P.ws;
    const bf16_t* Q = (const bf16_t*)(ws + WS_Q); const bf16_t* K = (const bf16_t*)(ws + WS_K); const bf16_t* V = (const bf16_t*)(ws + WS_V);
    bf16_t* NUM = (bf16_t*)(ws + WS_NUM); float* DEN = (float*)(ws + WS_DEN);
    const int tid = threadIdx.x, lane = tid & 63, w = __builtin_amdgcn_readfirstlane(tid >> 6);
    int n = (int)blockIdx.x; const int G = (int)gridDim.x;
    if (n < att::NUNIT) {
        att::Desc cur = att::decode(n); att::Stage S; bf16x8 qf[4];
        att::stage_load(S, cur, Q, K, V, tid, w, lane); att::stage_write(S, lds, tid);
#pragma unroll
        for (int ks = 0; ks < 4; ++ks) qf[ks] = S.q[ks];
        wg_sync();
        for (;;) {
            const int nn = n + G; const bool has = nn < att::NUNIT; att::Desc nxt = cur;
            if (has) { nxt = att::decode(nn); att::stage_load(S, nxt, Q, K, V, tid, w, lane); }
            att::compute(cur, qf, lds, NUM, DEN, w, lane);
            if (!has) break;
            ATT_BAR();
            att::stage_write(S, lds, tid);
#pragma unroll
            for (int ks = 0; ks < 4; ++ks) qf[ks] = S.q[ks];
            ATT_BAR();
            cur = nxt; n = nn;
        }
    }
    wg_sync();
}
#define XB_TMO      128
#define XB_XCNT(j)  (256  + 64 * (j))
#define XB_XSUB(j)  (1280 + 64 * (j))
#define XB_XGEN(j)  (2304 + 64 * (j))
#define XB_TOP      3328
#define XB_TOPGEN   3392
#define XCD_BAR_WORDS 3456
#define XB_SPIN_CAP (1u << 18)


__device__ __forceinline__ unsigned xb_ld(unsigned* p)              { return __hip_atomic_load(p, __ATOMIC_RELAXED, __HIP_MEMORY_SCOPE_AGENT); }
__device__ __forceinline__ unsigned xb_add(unsigned* p, unsigned v) { return __hip_atomic_fetch_add(p, v, __ATOMIC_RELAXED, __HIP_MEMORY_SCOPE_AGENT); }
__device__ __forceinline__ unsigned xb_xcc_id() { return (unsigned)__builtin_amdgcn_s_getreg((3 << 11) | 20) & 0xFu; }
#define XB_SPIN(cond, bar) do { unsigned _sp = 0; while (cond) { __builtin_amdgcn_s_sleep(1); \
    if ((++_sp & 255u) == 0u) { if (xb_ld(&(bar)[XB_TMO])) break; if (_sp > XB_SPIN_CAP) { atomicAdd(&(bar)[XB_TMO], 1u); break; } } } } while (0)

struct XcdBarrier {
    unsigned* bar; unsigned x;
    volatile LAS unsigned* st;
};

__device__ __forceinline__ XcdBarrier xcd_barrier_post(unsigned* bar, volatile LAS unsigned* st) {
    XcdBarrier b; b.bar = bar; b.x = xb_xcc_id(); b.st = st;
    if (threadIdx.x == 0) (void)xb_add(&bar[XB_XCNT(b.x)], 1u);
    return b;
}
__device__ __forceinline__ void xcd_barrier_complete(unsigned* bar, unsigned x, unsigned& nloc, unsigned& nx) {
    const unsigned G = gridDim.x * gridDim.y * gridDim.z;
    unsigned sum, cnt, mine, sp = 0u;
    for (;;) {
        sum = 0u; cnt = 0u; mine = 0u;
#pragma unroll
        for (unsigned j = 0; j < 16; ++j) { const unsigned c = xb_ld(&bar[XB_XCNT(j)]); sum += c; cnt += (c > 0u) ? 1u : 0u; mine = (j == x) ? c : mine; }
        if (sum == G) break;
        __builtin_amdgcn_s_sleep(1);
        if ((++sp & 255u) == 0u) { if (xb_ld(&bar[XB_TMO])) break; if (sp > XB_SPIN_CAP) { atomicAdd(&bar[XB_TMO], 1u); break; } }
    }
    nloc = mine > 0u ? mine : 1u; nx = cnt > 0u ? cnt : 1u;
}

__device__ __forceinline__ void xcd_barrier(const XcdBarrier& b) {
    asm volatile("s_waitcnt vmcnt(0)" ::: "memory");
    wg_sync();
    if (threadIdx.x == 0) {
        unsigned* bar = b.bar;
        __builtin_amdgcn_s_waitcnt(0);
        unsigned nloc = b.st[0], nx = b.st[1];
        if (nloc == 0u) { xcd_barrier_complete(bar, b.x, nloc, nx); b.st[0] = nloc; b.st[1] = nx; }
        const unsigned old = xb_add(&bar[XB_XSUB(b.x)], 1u);
        const unsigned gen = old / nloc;
        if (old + 1u == (gen + 1u) * nloc) {
            __builtin_amdgcn_fence(__ATOMIC_RELEASE, "agent");
            asm volatile("s_waitcnt vmcnt(0)" ::: "memory");
            const unsigned og = xb_add(&bar[XB_TOP], 1u);
            const unsigned tg = og / nx;
            if (og + 1u == (tg + 1u) * nx) xb_add(&bar[XB_TOPGEN], 1u);
            else XB_SPIN(xb_ld(&bar[XB_TOPGEN]) == tg, bar);
            __builtin_amdgcn_fence(__ATOMIC_ACQUIRE, "agent");
            xb_add(&bar[XB_XGEN(b.x)], 1u);
            asm volatile("s_waitcnt vmcnt(0)" ::: "memory");
        } else {
            XB_SPIN(xb_ld(&bar[XB_XGEN(b.x)]) == gen, bar);
            __builtin_amdgcn_fence(__ATOMIC_ACQUIRE, "agent");
            asm volatile("s_waitcnt vmcnt(0)" ::: "memory");
        }
    }
    wg_sync();
}

__device__ __forceinline__ void xcd_arrive(const XcdBarrier& b) {
    asm volatile("s_waitcnt vmcnt(0)" ::: "memory");
    wg_sync();
    if (threadIdx.x == 0) {
        unsigned* bar = b.bar;
        __builtin_amdgcn_s_waitcnt(0);
        unsigned nloc = b.st[0], nx = b.st[1];
        if (nloc == 0u) { xcd_barrier_complete(bar, b.x, nloc, nx); b.st[0] = nloc; b.st[1] = nx; }
        const unsigned old = xb_add(&bar[XB_XSUB(b.x)], 1u);
        const unsigned gen = old / nloc;
        if (old + 1u == (gen + 1u) * nloc) {
            __builtin_amdgcn_fence(__ATOMIC_RELEASE, "agent");
            asm volatile("s_waitcnt vmcnt(0)" ::: "memory");
            const unsigned og = xb_add(&bar[XB_TOP], 1u);
            const unsigned tg = og / nx;
            if (og + 1u == (tg + 1u) * nx) xb_add(&bar[XB_TOPGEN], 1u);
            xb_add(&bar[XB_XGEN(b.x)], 1u);
        }
        b.st[2] = gen;
    }
}
__device__ __forceinline__ void xcd_wait(const XcdBarrier& b) {
    if (threadIdx.x == 0) {
        unsigned* bar = b.bar; const unsigned gen = b.st[2];
        XB_SPIN(xb_ld(&bar[XB_TOPGEN]) == gen, bar);
        __builtin_amdgcn_fence(__ATOMIC_ACQUIRE, "agent");
        asm volatile("s_waitcnt vmcnt(0)" ::: "memory");
    }
    wg_sync();
}

__device__ __forceinline__ void xcd_wait_wave(unsigned* bar, volatile LAS unsigned* st, int lane) {
    if (lane == 0) { const unsigned gen = st[2]; XB_SPIN(xb_ld(&bar[XB_TOPGEN]) == gen, bar); }
    __builtin_amdgcn_fence(__ATOMIC_ACQUIRE, "agent");
    asm volatile("s_waitcnt vmcnt(0)" ::: "memory");
}
typedef float f32x16 __attribute__((ext_vector_type(16)));
namespace ssm {
constexpr int SLOT = 52224, OFF_BU = 0, OFF_X = 32768, OFF_U = 49152;
typedef float f32x2v __attribute__((ext_vector_type(2)));
__device__ __forceinline__ f32x2v gelu2(f32x2v v) {
    f32x2v av; av.x = fabsf(v.x); av.y = fabsf(v.y);
    const f32x2v d = av * 0.2316418882f + 1.0f;
    f32x2v t; t.x = __builtin_amdgcn_rcpf(d.x); t.y = __builtin_amdgcn_rcpf(d.y);
    f32x2v q = t * 0.5307027145f + (-0.7265760135f); q = q * t + 0.7107068705f; q = q * t + (-0.142248368f); q = q * t + 0.127414796f; q = q * t;
    const f32x2v s = (av * av) * (-0.72134752044f);
    f32x2v e; e.x = __builtin_amdgcn_exp2f(s.x); e.y = __builtin_amdgcn_exp2f(s.y);
    const f32x2v m = av * (q * e);
    f32x2v r; r.x = fmaxf(v.x, 0.f); r.y = fmaxf(v.y, 0.f);
    return r - m;
}
__device__ __forceinline__ void pair(const Params& P, int itA, int itB, LAS unsigned char* lds, const bool hidden) {
    const float* lam_re = P.in[6]; const float* lam_im = P.in[7]; const float* log_dt = P.in[8];
    const float* b_re = P.in[9]; const float* b_im = P.in[10]; const float* c_re = P.in[11]; const float* c_im = P.in[12]; const float* d_skip = P.in[13];
    const bf16_t* U = (const bf16_t*)(P.ws + WS_U); bf16_t* YG = (bf16_t*)(P.ws + WS_YG);
    const int tid = threadIdx.x, lane = tid & 63, c32 = lane & 31, hh = lane >> 5, i16 = lane & 15, g4 = lane >> 4;
    const int w = __builtin_amdgcn_readfirstlane(tid >> 6);
    const int slot = w < 4 ? (w & 1) : ((w >> 1) & 1);
    const int role = w < 2 ? 1 : (w < 4 ? 0 : 2 + (w & 1));
    const int it = slot ? itB : itA;
    const bool live = it < NB * NG;
    const int b = live ? it / NG : 0, g = live ? it % NG : 0;
    LAS unsigned char* sb = lds + slot * SLOT;
    const bf16_t* ub = U + (size_t)(b * NG + g) * SEQ * GC;
    float ar = 0.f, ai = 0.f; bf16x8 bfr[2][2]; bf16x8 cfr[4]; f32x4 dsk = (f32x4){0.f, 0.f, 0.f, 0.f};
#pragma unroll
    for (int q = 0; q < 2; ++q) { bfr[q][0] = (bf16x8){0, 0, 0, 0, 0, 0, 0, 0}; bfr[q][1] = bfr[q][0]; }
#pragma unroll
    for (int ks = 0; ks < 4; ++ks) cfr[ks] = (bf16x8){0, 0, 0, 0, 0, 0, 0, 0};
    if (role < 2) {
        const float dt = expf(log_dt[g]);
#pragma unroll
        for (int q = 0; q < 2; ++q) {
            const int n = 32 * q + c32;
            const float lr = lam_re[g * NS + n], li = lam_im[g * NS + n];
            const float mag = expf(lr * dt); float sn, cs; sincosf(li * dt, &sn, &cs);
            const float a_r = mag * cs, a_i = mag * sn;
            const float dn = lr * lr + li * li, nr = a_r - 1.f;
            const float cr = (nr * lr + a_i * li) / dn, ci = (a_i * lr - nr * li) / dn;
            if (q == hh) { ar = a_r; ai = a_i; }
            const f32x4* brp = (const f32x4*)(b_re + (size_t)(g * NS + n) * GC + 8 * hh); const f32x4* bip = (const f32x4*)(b_im + (size_t)(g * NS + n) * GC + 8 * hh);
            const f32x4 br0 = brp[0], br1 = brp[1], bi0 = bip[0], bi1 = bip[1];
            const f32x4 re0 = br0 * cr - bi0 * ci, re1 = br1 * cr - bi1 * ci, im0 = bi0 * cr + br0 * ci, im1 = bi1 * cr + br1 * ci;
            u32x4 wre, wim;
            wre.x = cvtpk(re0[0], re0[1]); wre.y = cvtpk(re0[2], re0[3]); wre.z = cvtpk(re1[0], re1[1]); wre.w = cvtpk(re1[2], re1[3]);
            wim.x = cvtpk(im0[0], im0[1]); wim.y = cvtpk(im0[2], im0[3]); wim.z = cvtpk(im1[0], im1[1]); wim.w = cvtpk(im1[2], im1[3]);
            bfr[q][0] = __builtin_bit_cast(bf16x8, wre); bfr[q][1] = __builtin_bit_cast(bf16x8, wim);
        }
    } else {
#pragma unroll
        for (int ks = 0; ks < 4; ++ks) {
            const int n0 = 16 * ks + 4 * g4;
            const f32x4 cre = *(const f32x4*)(c_re + (size_t)(g * GC + i16) * NS + n0), cim = *(const f32x4*)(c_im + (size_t)(g * GC + i16) * NS + n0);
            u32x4 wc; wc.x = cvtpk(cre[0], -cim[0]); wc.y = cvtpk(cre[1], -cim[1]); wc.z = cvtpk(cre[2], -cim[2]); wc.w = cvtpk(cre[3], -cim[3]);
            cfr[ks] = __builtin_bit_cast(bf16x8, wc);
        }
        dsk = *(const f32x4*)(d_skip + g * GC + 4 * g4);
    }
    float xr = 0.f, xi = 0.f;
    const float a2r = ar * ar - ai * ai, a2i = 2.f * ar * ai;
    constexpr int NT = SEQ / 32;
#define SSM_BAR() do { asm volatile("s_waitcnt lgkmcnt(0)" ::: "memory"); __builtin_amdgcn_s_barrier(); asm volatile("" ::: "memory"); } while (0)
    if (role == 0) {
        const bf16_t* up = ub + c32 * GC + 8 * hh;
        bf16x8 aA = __builtin_nontemporal_load((const bf16x8*)up), aB = __builtin_nontemporal_load((const bf16x8*)(up + 32 * GC));
#define SSM_PRODUCE(step_, a_) do { \
            LAS unsigned char* wb = sb + OFF_BU + ((step_) & 1) * 16384; \
            *(LAS bf16x8*)(sb + OFF_U + ((step_) % 3) * 1024 + c32 * 32 + hh * 16) = (a_);     \
            _Pragma("unroll") for (int q = 0; q < 2; ++q) { \
                f32x16 z = {0.f, 0.f, 0.f, 0.f, 0.f, 0.f, 0.f, 0.f, 0.f, 0.f, 0.f, 0.f, 0.f, 0.f, 0.f, 0.f}; \
                const f32x16 dre = __builtin_amdgcn_mfma_f32_32x32x16_bf16((a_), bfr[q][0], z, 0, 0, 0); \
                const f32x16 dim = __builtin_amdgcn_mfma_f32_32x32x16_bf16((a_), bfr[q][1], z, 0, 0, 0); \
                _Pragma("unroll") for (int r = 0; r < 16; ++r) { const int tau = (r & 3) + 8 * (r >> 2) + 4 * hh; \
                    *(LAS float*)(wb + (tau >> 1) * 1024 + 16 * (32 * q + c32) + 8 * (tau & 1)) = dre[r]; *(LAS float*)(wb + (tau >> 1) * 1024 + 16 * (32 * q + c32) + 8 * (tau & 1) + 4) = dim[r]; } \
            } } while (0)
        for (int step = 0; step < NT; step += 2) {
            SSM_PRODUCE(step, aA);
            aA = __builtin_nontemporal_load((const bf16x8*)(up + (size_t)(step + 2 < NT ? step + 2 : NT - 1) * 32 * GC));
            SSM_BAR();
            SSM_PRODUCE(step + 1, aB);
            aB = __builtin_nontemporal_load((const bf16x8*)(up + (size_t)(step + 3 < NT ? step + 3 : NT - 1) * 32 * GC));
            SSM_BAR();
        }
        SSM_BAR(); SSM_BAR();
#undef SSM_PRODUCE
    } else if (role == 1) {
        unsigned xoff[2][16];
#pragma unroll
        for (int p = 0; p < 2; ++p)
#pragma unroll
            for (int k = 0; k < 16; ++k) xoff[p][k] = (unsigned)(OFF_X + p * 8192 + k * 256 + 16 * ((lane >> 2) ^ k) + 4 * (lane & 3));
#define SSM_SCAN(par_) do { \
            LAS const unsigned char* rb = sb + OFF_BU + (par_) * 16384 + 16 * lane; \
            f32x4 b2[16]; \
            _Pragma("unroll") for (int j = 0; j < 16; ++j) b2[j] = *(LAS const f32x4*)(rb + j * 1024);     \
            _Pragma("unroll") for (int j = 0; j < 16; ++j) { \
                { const float nr = fmaf(ar, xr, fmaf(-ai, xi, b2[j][0])); xi = fmaf(ar, xi, fmaf(ai, xr, b2[j][1])); xr = nr; } \
                *(LAS unsigned*)(sb + xoff[par_][(2 * j) & 15] + ((2 * j) >> 4) * 4096) = cvtpk(xr, xi); \
                { const float nr = fmaf(ar, xr, fmaf(-ai, xi, b2[j][2])); xi = fmaf(ar, xi, fmaf(ai, xr, b2[j][3])); xr = nr; } \
                *(LAS unsigned*)(sb + xoff[par_][(2 * j + 1) & 15] + ((2 * j + 1) >> 4) * 4096) = cvtpk(xr, xi); \
            } } while (0)
        SSM_BAR();
        for (int step = 1; step <= NT; step += 2) {
            SSM_SCAN(0); SSM_BAR();
            SSM_SCAN(1); SSM_BAR();
        }
        SSM_BAR();
#undef SSM_SCAN
    } else {
#define SSM_CONSUME(step_) do { \
            const int tile = (step_) - 2, tau = 16 * (role - 2) + i16, tok = tile * 32 + tau; \
            LAS const unsigned char* xb = sb + OFF_X + (tile & 1) * 8192; \
            const unsigned long long uw = *(LAS const unsigned long long*)(sb + OFF_U + (tile % 3) * 1024 + tau * 32 + g4 * 8); \
            f32x4 acc = (f32x4){0.f, 0.f, 0.f, 0.f}; \
            _Pragma("unroll") for (int ks = 0; ks < 4; ++ks) { \
                const bf16x8 xf = *(LAS const bf16x8*)(xb + tau * 256 + 16 * ((4 * ks + g4) ^ (tau & 15))); \
                acc = __builtin_amdgcn_mfma_f32_16x16x32_bf16(cfr[ks], xf, acc, 0, 0, 0); } \
            const unsigned u0 = (unsigned)uw, u1 = (unsigned)(uw >> 32); \
            const f32x2v ya = gelu2((f32x2v){acc[0] + dsk[0] * bflo(u0), acc[1] + dsk[1] * bfhi(u0)}), yb = gelu2((f32x2v){acc[2] + dsk[2] * bflo(u1), acc[3] + dsk[3] * bfhi(u1)}); \
            const float y0 = ya.x, y1 = ya.y, y2 = yb.x, y3 = yb.y; \
            if (live) *(unsigned long long*)(YG + ((size_t)b * SEQ + tok) * AW + g * GC + 4 * g4) = (unsigned long long)cvtpk(y0, y1) | ((unsigned long long)cvtpk(y2, y3) << 32); \
        } while (0)
        if (hidden) {
            const bf16_t* NUM = (const bf16_t*)(P.ws + WS_NUM); const float* DEN = (const float*)(P.ws + WS_DEN); const bf16_t* GA = (const bf16_t*)(P.ws + WS_GA);
            bf16_t* MIX = (bf16_t*)(P.ws + WS_MIX); const f32x4* pin = (const f32x4*)P.in[1]; unsigned long long* PB8 = (unsigned long long*)(P.ws + WS_PB);
            const size_t hbase = ((size_t)blockIdx.x * 4 + (w - 4)) * 64 + lane, hstride = (size_t)gridDim.x * 256;
            u32x4 mn0[2], mn1[2], mn2[2], mga[2]; float md0[2], md1[2], md2[2]; f32x4 pv;
#define H_ISSUE_M(k_, B_) do { const size_t i_ = hbase + (size_t)(k_) * hstride; const int row_ = (int)(i_ >> 6), c8_ = (int)(i_ & 63) * 8, h_ = c8_ >> 6; \
                md0[B_] = DEN[(size_t)row_ * NH + h_]; md1[B_] = DEN[((size_t)T + row_) * NH + h_]; md2[B_] = DEN[((size_t)2 * T + row_) * NH + h_]; \
                mn0[B_] = *(const u32x4*)(NUM + (size_t)row_ * AW + c8_); mn1[B_] = *(const u32x4*)(NUM + ((size_t)T + row_) * AW + c8_); mn2[B_] = *(const u32x4*)(NUM + ((size_t)2 * T + row_) * AW + c8_); \
                mga[B_] = __builtin_nontemporal_load((const u32x4*)(GA + (size_t)row_ * AW + c8_)); } while (0)
#define H_FINISH_M(k_, B_) do { const size_t i_ = hbase + (size_t)(k_) * hstride; const int row_ = (int)(i_ >> 6), c8_ = (int)(i_ & 63) * 8; \
                const float inv_ = __builtin_amdgcn_rcpf(md0[B_] + md1[B_] + md2[B_]); u32x4 o_; \
                _Pragma("unroll") for (int j = 0; j < 4; ++j) { const float lo_ = (bflo(mn0[B_][j]) + bflo(mn1[B_][j]) + bflo(mn2[B_][j])) * inv_ * bflo(mga[B_][j]); \
                    const float hi_ = (bfhi(mn0[B_][j]) + bfhi(mn1[B_][j]) + bfhi(mn2[B_][j])) * inv_ * bfhi(mga[B_][j]); o_[j] = cvtpk(lo_, hi_); } \
                *(u32x4*)(MIX + (size_t)row_ * DM + c8_) = o_; } while (0)
#define H_ISSUE_P(k_) do { pv = __builtin_nontemporal_load(pin + hbase + (size_t)(k_) * hstride); } while (0)
#define H_FINISH_P(k_) do { __builtin_nontemporal_store((unsigned long long)cvtpk(pv.x, pv.y) | ((unsigned long long)cvtpk(pv.z, pv.w) << 32), PB8 + hbase + (size_t)(k_) * hstride); } while (0)
            SSM_BAR();
            H_ISSUE_P(0); SSM_BAR();
            SSM_CONSUME(2); SSM_BAR();
            H_FINISH_P(0); H_ISSUE_P(1); SSM_CONSUME(3); SSM_BAR();
            SSM_CONSUME(4); SSM_BAR();
            H_FINISH_P(1); H_ISSUE_P(2); SSM_CONSUME(5); SSM_BAR();
            SSM_CONSUME(6); SSM_BAR();
            H_FINISH_P(2); H_ISSUE_P(3); SSM_CONSUME(7); SSM_BAR();
            xcd_wait_wave((unsigned*)(P.ws + WS_CTL), (volatile LAS unsigned*)(lds + LDSCTL_OFF), lane);
            for (int m = 4; m < 32; m += 2) {
                if (m - 4 < MERGE_HIDDEN) H_ISSUE_M(m - 4, 0);
                SSM_CONSUME(2 * m); SSM_BAR();
                if (m > 4 && m - 5 < MERGE_HIDDEN) H_FINISH_M(m - 5, 1);
                H_FINISH_P(m - 1); H_ISSUE_P(m); SSM_CONSUME(2 * m + 1); SSM_BAR();
                if (m - 3 < MERGE_HIDDEN) H_ISSUE_M(m - 3, 1);
                SSM_CONSUME(2 * m + 2); SSM_BAR();
                if (m - 4 < MERGE_HIDDEN) H_FINISH_M(m - 4, 0);
                H_FINISH_P(m); H_ISSUE_P(m + 1); SSM_CONSUME(2 * m + 3); SSM_BAR();
            }
            SSM_CONSUME(64); SSM_BAR();
            if (27 < MERGE_HIDDEN) H_FINISH_M(27, 1);
            H_FINISH_P(31); SSM_CONSUME(65); SSM_BAR();
#undef H_ISSUE_M
#undef H_FINISH_M
#undef H_ISSUE_P
#undef H_FINISH_P
        } else {
            SSM_BAR(); SSM_BAR();
            for (int step = 2; step < NT + 2; ++step) { SSM_CONSUME(step); SSM_BAR(); }
        }
#undef SSM_CONSUME
    }
#undef SSM_BAR
    wg_sync();
}
}
__device__ __forceinline__ void ph_ssm(const Params& P, LAS unsigned char* lds, const bool hidden) {
    for (int pr = (int)blockIdx.x; 2 * pr < NB * NG; pr += (int)gridDim.x) ssm::pair(P, 2 * pr, 2 * pr + 1, lds, hidden);
}
__device__ __forceinline__ void ph_merge(const Params& P, const Ctx& c) {
    unsigned char* ws = P.ws;
    const bf16_t* NUM = (const bf16_t*)(ws + WS_NUM); const float* DEN = (const float*)(ws + WS_DEN); const bf16_t* GA = (const bf16_t*)(ws + WS_GA); bf16_t* MIX = (bf16_t*)(ws + WS_MIX);
    for (size_t i = c.gtid; i < (size_t)T * 64; i += c.nthr) {
        const int row = (int)(i >> 6), c8 = (int)(i & 63) * 8, h = c8 >> 6;
        const float den = DEN[(size_t)row * NH + h] + DEN[((size_t)T + row) * NH + h] + DEN[((size_t)2 * T + row) * NH + h];
        const float inv = 1.0f / den;
        const u32x4 n0 = *(const u32x4*)(NUM + (size_t)row * AW + c8), n1 = *(const u32x4*)(NUM + ((size_t)T + row) * AW + c8), n2 = *(const u32x4*)(NUM + ((size_t)2 * T + row) * AW + c8);
        const u32x4 ga = *(const u32x4*)(GA + (size_t)row * AW + c8);
        u32x4 o;
#pragma unroll
        for (int j = 0; j < 4; ++j) { const float lo = (bflo(n0[j]) + bflo(n1[j]) + bflo(n2[j])) * inv * bflo(ga[j]); const float hi = (bfhi(n0[j]) + bfhi(n1[j]) + bfhi(n2[j])) * inv * bfhi(ga[j]); o[j] = pk2(lo, hi); }
        *(u32x4*)(MIX + (size_t)row * DM + c8) = o;
    }
}
__device__ __forceinline__ void ph_merge_rest(const Params& P) {
    unsigned char* ws = P.ws;
    const bf16_t* NUM = (const bf16_t*)(ws + WS_NUM); const float* DEN = (const float*)(ws + WS_DEN); const bf16_t* GA = (const bf16_t*)(ws + WS_GA); bf16_t* MIX = (bf16_t*)(ws + WS_MIX);
    const int w = (int)threadIdx.x >> 6, lane = (int)threadIdx.x & 63;
    const size_t hbase = ((size_t)blockIdx.x * 4 + (w & 3)) * 64 + lane, hstride = (size_t)gridDim.x * 256;
#pragma unroll 4
    for (int k = MERGE_HIDDEN + (w >> 2); k < 32; k += 2) {
        const size_t i = hbase + (size_t)k * hstride; const int row = (int)(i >> 6), c8 = (int)(i & 63) * 8, h = c8 >> 6;
        const float den = DEN[(size_t)row * NH + h] + DEN[((size_t)T + row) * NH + h] + DEN[((size_t)2 * T + row) * NH + h];
        const float inv = __builtin_amdgcn_rcpf(den);
        const u32x4 n0 = *(const u32x4*)(NUM + (size_t)row * AW + c8), n1 = *(const u32x4*)(NUM + ((size_t)T + row) * AW + c8), n2 = *(const u32x4*)(NUM + ((size_t)2 * T + row) * AW + c8);
        const u32x4 ga = __builtin_nontemporal_load((const u32x4*)(GA + (size_t)row * AW + c8));
        u32x4 o;
#pragma unroll
        for (int j = 0; j < 4; ++j) { const float lo = (bflo(n0[j]) + bflo(n1[j]) + bflo(n2[j])) * inv * bflo(ga[j]); const float hi = (bfhi(n0[j]) + bfhi(n1[j]) + bfhi(n2[j])) * inv * bfhi(ga[j]); o[j] = cvtpk(lo, hi); }
        *(u32x4*)(MIX + (size_t)row * DM + c8) = o;
    }
}
constexpr int XCNT_WORD0 = 3456 + 64;
struct InOrder : pg8::StaticOrder {
    const float* x; bf16_t* XB; float* rr; unsigned* cnt; int stag, slot, row0, lane;
    __device__ __forceinline__ void a_ready(const pg8::Unit& u) const {
        if (stag && (u.pm & 15) >= 8 && u.pn < 4) {
            if (threadIdx.x < 64) {
                unsigned sp = 0u;
                while ((unsigned)__builtin_amdgcn_readfirstlane(__hip_atomic_load(cnt, __ATOMIC_RELAXED, __HIP_MEMORY_SCOPE_AGENT)) < 256u) { __builtin_amdgcn_s_sleep(2); if (++sp > (1u << 20)) break; }
                __builtin_amdgcn_fence(__ATOMIC_ACQUIRE, "agent");
                asm volatile("s_waitcnt vmcnt(0)" ::: "memory");
            }
            asm volatile("" ::: "memory"); __builtin_amdgcn_s_barrier(); asm volatile("" ::: "memory");
        }
    }
    __device__ __forceinline__ void done(const pg8::Unit& u) const {
        if (stag && (u.pm & 15) < 8 && (u.pn >> 2) == slot) {
            convert_rows_wt(x, XB, rr, row0, lane);
            if (lane == 0) __hip_atomic_fetch_add(cnt, 1u, __ATOMIC_RELAXED, __HIP_MEMORY_SCOPE_AGENT);
        }
    }
};
__device__ __forceinline__ void ph_inproj(const Params& P, LAS unsigned char* lds) {
    unsigned char* ws = P.ws;
    pg8::Gemm g{(const bf16_t*)(ws + WS_XB), (const bf16_t*)(ws + WS_WINT), T, INW, DM}; InOrder S; S.init(T, INW, (int)gridDim.x, (int)blockIdx.x);
    const int c = (int)blockIdx.x, lbl = c & 7, w = (int)threadIdx.x >> 6;
    S.x = P.in[0]; S.XB = (bf16_t*)(ws + WS_XB); S.rr = (float*)(ws + WS_RRMSX); S.cnt = (unsigned*)(ws + WS_CTL) + XCNT_WORD0 + 64 * lbl;
    S.stag = gridDim.x == 256; S.slot = (c >> 3) & 1; S.lane = (int)threadIdx.x & 63;
    S.row0 = (16 * lbl + 8) * 256 + ((c >> 3) * 8 + w) * 8;
    pg8::EpiInProj E{(const float*)(ws + WS_RRMSX), P.in[4], P.in[5], (bf16_t*)(ws + WS_Q), (bf16_t*)(ws + WS_K), (bf16_t*)(ws + WS_V), (bf16_t*)(ws + WS_GA), (bf16_t*)(ws + WS_GS), (bf16_t*)(ws + WS_U)};
    pg8::gemm_phase<pg8::EpiInProj, InOrder, true, true>(lds, g, S, E);
}
__device__ __forceinline__ void ph_glu(const Params& P, LAS unsigned char* lds) {
    unsigned char* ws = P.ws;
    pg8::Gemm g{(const bf16_t*)(ws + WS_YG), (const bf16_t*)(ws + WS_WGLUT), T, AW, AW}; pg8::StaticOrder S; S.init(T, AW, (int)gridDim.x, (int)blockIdx.x);
    pg8::EpiGlu E{P.in[15], (const bf16_t*)(ws + WS_YG), (const bf16_t*)(ws + WS_GS), (bf16_t*)(ws + WS_MIX)};
    pg8::gemm_phase<pg8::EpiGlu, pg8::StaticOrder, true, true>(lds, g, S, E);
}
__device__ __forceinline__ void gemm_out(const Params& P, LAS unsigned char* lds) {
    unsigned char* ws = P.ws;
    pg8::Gemm g{(const bf16_t*)(ws + WS_MIX), (const bf16_t*)(ws + WS_WOUTT), T, DM, DM}; pg8::StaticOrder S; S.init(T, DM, (int)gridDim.x, (int)blockIdx.x);
    pg8::EpiOut E{(const bf16_t*)(ws + WS_XB), (bf16_t*)(ws + WS_HB), (float*)(ws + WS_SSPART)};
    pg8::gemm_phase<pg8::EpiOut, pg8::StaticOrder, true, true>(lds, g, S, E);
}
struct SubOrder {
    pg8::StaticOrder S; int first, count;
    __device__ __forceinline__ bool next(int i, pg8::Unit& u) const { return i < count && S.next(first + i, u); }
    __device__ __forceinline__ void a_ready(const pg8::Unit&) const {}
    __device__ __forceinline__ void done(const pg8::Unit&) const {}
};
__device__ __forceinline__ void gemm_proj(const Params& P, LAS unsigned char* lds, int first, int count) {
    unsigned char* ws = P.ws;
    pg8::Gemm g{(const bf16_t*)(ws + WS_PB), (const bf16_t*)(ws + WS_WPT), T, DM, PLE}; SubOrder S; S.S.init(T, DM, (int)gridDim.x, (int)blockIdx.x); S.first = first; S.count = count;
    pg8::EpiProj E{(bf16_t*)(ws + WS_PROJ)};
    pg8::gemm_phase<pg8::EpiProj, SubOrder, true, true>(lds, g, S, E);
}
__device__ __forceinline__ void ph_outproj(const Params& P, LAS unsigned char* lds) {
    gemm_out(P, lds);
}
__device__ __forceinline__ void ph_gate(const Params& P, LAS unsigned char* lds) {
    unsigned char* ws = P.ws;
    pg8::Gemm g{(const bf16_t*)(ws + WS_HB), (const bf16_t*)(ws + WS_WGT), T, DM, DM}; pg8::StaticOrder S; S.init(T, DM, (int)gridDim.x, (int)blockIdx.x);
    { float* RRH = (float*)(ws + WS_RRMSH); const float* SSP = (const float*)(ws + WS_SSPART); pg8::Unit u;
      for (int i = 0; S.next(i, u); ++i)
          for (int rr = (int)threadIdx.x; rr < 256; rr += 512) { const int r = u.pm * 256 + rr; const f32x4* sp = (const f32x4*)(SSP + (size_t)r * 16); const f32x4 t4 = (sp[0] + sp[1]) + (sp[2] + sp[3]);
              RRH[r] = __builtin_amdgcn_rsqf(((t4[0] + t4[1]) + (t4[2] + t4[3])) * (1.f / DM) + EPS); }
      wg_sync(); }
    pg8::EpiGate E{(const float*)(ws + WS_RRMSH), (const bf16_t*)(ws + WS_PROJ), (const bf16_t*)(ws + WS_HB), P.out};
    pg8::gemm_phase<pg8::EpiGate, pg8::StaticOrder, true, true>(lds, g, S, E);
}

constexpr int NPHASE = 6;
__global__ void __launch_bounds__(512, 2) mega(Params P) {
    extern __shared__ __attribute__((aligned(16))) unsigned char lds_raw[];
    LAS unsigned char* lds = (LAS unsigned char*)lds_raw;
    Ctx c; c.lane = threadIdx.x & 63; c.gtid = blockIdx.x * 512 + threadIdx.x; c.nthr = gridDim.x * 512; c.gwave = c.gtid >> 6; c.nwaves = c.nthr >> 6;
    cg::grid_group grid = cg::this_grid();
    volatile LAS unsigned* xbst = (volatile LAS unsigned*)(lds + LDSCTL_OFF);
    if (threadIdx.x < 4) xbst[threadIdx.x] = 0u;
    wg_sync();
    XcdBarrier xbar = xcd_barrier_post((unsigned*)(P.ws + WS_CTL), xbst);
    const int lo = P.ph_lo, hi = P.ph_hi;
#define IN(k) (lo <= (k) && (k) < hi)
#define SEAM(k) do { if (IN(k) && IN((k) + 1)) { if (P.use_cg) grid.sync(); else xcd_barrier(xbar); } } while (0)
#ifndef REP
#define REP -1
#endif
#define RUN(k, body) do { if (IN(k)) { body; if (REP == (k)) { wg_sync(); body; } } } while (0)
#define ARRIVE(k) do { if (IN(k) && IN((k) + 1) && !P.use_cg) xcd_arrive(xbar); } while (0)
#define WAIT(k) do { if (IN(k) && IN((k) + 1)) { if (P.use_cg) grid.sync(); else xcd_wait(xbar); } } while (0)
    RUN(0, ph_prep(P, c, lds));
    ARRIVE(0);
    if (IN(1)) { ph_prep_late(P, c, lds, 0); wg_sync(); }
    WAIT(0);
    RUN(1, ph_inproj(P, lds));
    ARRIVE(1);
    if (IN(2)) { ph_prep_late(P, c, lds, 1); wg_sync(); }
    WAIT(1);
    const bool hid = (gridDim.x == 256) && IN(2) && IN(3);
    if (IN(2)) {
        ph_attn(P, lds);
        if (hid) xcd_arrive(xbar); else ph_prep_p(P, c);
        ph_ssm(P, lds, hid);
    }
    ARRIVE(2);
    if (hid) ph_merge_rest(P);
    WAIT(2);
    if (IN(3)) { if (hid) ph_glu(P, lds); else if (blockIdx.x & 1) { ph_glu(P, lds); ph_merge(P, c); } else { ph_merge(P, c); ph_glu(P, lds); } }
    ARRIVE(3);
    if (IN(4)) gemm_proj(P, lds, 0, 1);
    WAIT(3);
    RUN(4, ph_outproj(P, lds));
    ARRIVE(4);
    if (IN(4)) gemm_proj(P, lds, 1, 1 << 20);
    WAIT(4);
    if (IN(5)) ph_gate(P, lds);
    if (REP == 45) { xcd_barrier(xbar); ph_outproj(P, lds); xcd_barrier(xbar); ph_gate(P, lds); }
#undef IN
#undef SEAM
}

extern "C" void kernel_launch(void* const* d_in, const int* in_sizes, int n_in, void* d_out, int out_size, void* d_ws, size_t ws_size, hipStream_t stream) {
    static int grid = 0;
    if (grid == 0) {
        int dev = 0, cus = 0, per_cu = 0;
        (void)hipGetDevice(&dev); (void)hipDeviceGetAttribute(&cus, hipDeviceAttributeMultiprocessorCount, dev);
        if (hipFuncSetAttribute((const void*)mega, hipFuncAttributeMaxDynamicSharedMemorySize, LDS_BYTES) != hipSuccess) fprintf(stderr, "kernel_launch: hipFuncSetAttribute failed\n");
        (void)hipOccupancyMaxActiveBlocksPerMultiprocessor(&per_cu, (const void*)mega, 512, LDS_BYTES);
        if (per_cu < 1) { fprintf(stderr, "kernel_launch: occupancy query says %d blocks per CU\n", per_cu); per_cu = 1; }
        grid = cus;
        if (n_in != 20 || ws_size < WS_END) { fprintf(stderr, "kernel_launch: unexpected n_in %d / ws %zu\n", n_in, ws_size); }
    }
    (void)hipMemsetAsync((char*)d_ws + WS_CTL, 0, (XCD_BAR_WORDS + 64 + 8 * 64) * 4, stream);
    Params p{};
    for (int i = 0; i < 20; ++i) p.in[i] = (const float*)d_in[i];
    p.out = (float*)d_out; p.ws = (unsigned char*)d_ws;
#if N_LAUNCH == 1
    p.ph_lo = 0; p.ph_hi = NPHASE;
    void* args[] = {&p};
    hipError_t e = hipLaunchCooperativeKernel((const void*)mega, dim3(grid), dim3(512), args, LDS_BYTES, stream);
    if (e != hipSuccess) fprintf(stderr, "cooperative launch failed: %s (grid %d)\n", hipGetErrorString(e), grid);
#else
    for (int ph = 0; ph < NPHASE; ++ph) { p.ph_lo = ph; p.ph_hi = ph + 1; hipLaunchKernelGGL(mega, dim3(grid), dim3(512), LDS_BYTES, stream, p); }
#endif
}
```

```cpp
#include <hip/hip_runtime.h>
#include <hip/hip_cooperative_groups.h>
#include <cstdio>
#include <cstdint>
namespace cg = cooperative_groups;

#ifndef N_LAUNCH
#define N_LAUNCH 1
#endif

typedef unsigned short bf16_t;
typedef short bf16x8 __attribute__((ext_vector_type(8)));
typedef float f32x4 __attribute__((ext_vector_type(4)));
typedef unsigned u32x4 __attribute__((ext_vector_type(4)));

constexpr int NB = 16, SEQ = 2048, DM = 1024, T = NB * SEQ, AW = 512, NH = 8, HD = 64, NG = 32, NS = 64, GC = 16, PLE = 256, INW = 3072;
constexpr float EPS = 1e-6f;
constexpr float QSCALE = 0.125f * 1.4426950408889634f;

constexpr size_t MiB = 1u << 20;
constexpr size_t WS_CTL = 0;
constexpr size_t WS_WINT = 1 * MiB, WS_WGLUT = 7 * MiB, WS_WOUTT = 8 * MiB, WS_WGT = 10 * MiB, WS_WPT = 12 * MiB;
constexpr size_t WS_RRMSX = 13 * MiB, WS_RRMSH = 13 * MiB + 256 * 1024;
constexpr size_t WS_DEN = 14 * MiB;
constexpr size_t WS_SSPART = 17 * MiB;
constexpr size_t WS_W32T = 20 * MiB;
constexpr size_t WS_XB = 32 * MiB, WS_HB = 32 * MiB;
constexpr size_t WS_PB = 96 * MiB;
constexpr size_t WS_Q = 112 * MiB, WS_K = 144 * MiB, WS_V = 176 * MiB, WS_MIX = 144 * MiB;
constexpr size_t WS_GA = 208 * MiB, WS_GS = 240 * MiB, WS_U = 272 * MiB;
constexpr size_t WS_NUM = 304 * MiB, WS_PROJ = 304 * MiB;
constexpr size_t WS_YG = 400 * MiB, WS_END = 432 * MiB;

constexpr int LDS_BYTES = 163840;

constexpr int MERGE_HIDDEN = 28;
constexpr int LDSCTL_OFF = 163840 - 64;
struct Params { const float* in[20]; float* out; unsigned char* ws; int ph_lo; int ph_hi; int use_cg; int pad; };

__device__ __forceinline__ unsigned f2bf(float f) { unsigned u = __float_as_uint(f); return (u + 0x7fffu + ((u >> 16) & 1u)) >> 16; }
__device__ __forceinline__ float bf2f(unsigned b) { return __uint_as_float(b << 16); }
__device__ __forceinline__ unsigned pk2(float lo, float hi) { return f2bf(lo) | (f2bf(hi) << 16); }
__device__ __forceinline__ float bflo(unsigned w) { return __uint_as_float(w << 16); }
__device__ __forceinline__ float bfhi(unsigned w) { return __uint_as_float(w & 0xffff0000u); }
typedef float f32x2_t __attribute__((ext_vector_type(2))); typedef __bf16 bf16x2_t __attribute__((ext_vector_type(2)));
__device__ __forceinline__ unsigned cvtpk(float lo, float hi) { f32x2_t v = {lo, hi}; bf16x2_t b = __builtin_convertvector(v, bf16x2_t); return __builtin_bit_cast(unsigned, b); }
__device__ __forceinline__ float wave_sum(float v) {
#pragma unroll
    for (int o = 1; o < 64; o <<= 1) v += __shfl_xor(v, o);
    return v;
}
__device__ __forceinline__ float silu_f(float v) { return v * __builtin_amdgcn_rcpf(1.f + __builtin_amdgcn_exp2f(v * -1.4426950408889634f)); }
__device__ __forceinline__ float sigmoid_f(float v) { return __builtin_amdgcn_rcpf(1.f + __builtin_amdgcn_exp2f(v * -1.4426950408889634f)); }
__device__ __forceinline__ int pi_col(int p) { const int t = p >> 8, w = p & 255, bj = w >> 7, wc = (w >> 5) & 3, i = w & 31; return (t << 8) + (wc << 6) + (bj << 5) + i; }

#define LAS __attribute__((address_space(3)))
__device__ __forceinline__ void wg_sync() { __builtin_amdgcn_fence(__ATOMIC_RELEASE, "workgroup"); __builtin_amdgcn_s_barrier(); __builtin_amdgcn_fence(__ATOMIC_ACQUIRE, "workgroup"); }
__device__ __forceinline__ float xsum16(float v) { const auto r = __builtin_amdgcn_permlane16_swap(__float_as_uint(v), __float_as_uint(v), false, false); return __uint_as_float(r[0]) + __uint_as_float(r[1]); }
__device__ __forceinline__ float xsum32(float v) { const auto r = __builtin_amdgcn_permlane32_swap(__float_as_uint(v), __float_as_uint(v), false, false); return __uint_as_float(r[0]) + __uint_as_float(r[1]); }
struct Ctx { int gtid, nthr, gwave, nwaves, lane; };
namespace pg8 {
#define PG8_LAS __attribute__((address_space(3)))
typedef unsigned short bf16_t;
typedef short bf16x8 __attribute__((ext_vector_type(8)));
typedef float f32x4 __attribute__((ext_vector_type(4)));
typedef unsigned u32x4 __attribute__((ext_vector_type(4)));
constexpr int BM = 256, BK = 64, HALF = 128, HTB = HALF * BK * 2  , STAGE_BYTES = 8 * HTB, NXCD = 8, WGM = 8;

__host__ __device__ __forceinline__ int lds_byte(int r, int c) { const int st = (r >> 4) * 2 + (c >> 5), rr = r & 15, cc = c & 31, ob = rr * 64 + cc * 2; return st * 1024 + (ob ^ (((ob >> 9) & 1) << 5)); }
__host__ __device__ __forceinline__ void stage_rc(int b, int& R, int& C) { const int st = b / 1024, sb = b % 1024, swz = sb ^ (((sb >> 9) & 1) << 5); R = (st >> 1) * 16 + swz / 64; C = (st & 1) * 32 + (swz % 64) / 2; }
__host__ __device__ __forceinline__ int perm32(int rho) { const int n = rho >> 4, i = rho & 15; return 8 * (i >> 2) + 4 * n + (i & 3); }

struct Unit { int pm, pn; };
struct Gemm { const bf16_t* A; const bf16_t* Bt; int M, N, K; };

struct StaticOrder {
    int nM, nN, nwg, G, c;
    __host__ __device__ void init(int M, int N, int G_, int c_) { nM = M / BM; nN = N / BM; nwg = nM * nN; G = G_; c = c_; }
    __host__ __device__ bool next(int i, Unit& u) const {
        const long L = (long)i * G + c; if (L >= nwg) return false;
        int wgid = (int)L; { const int q = nwg / NXCD, r = nwg % NXCD, xcd = wgid % NXCD, off = wgid / NXCD; wgid = (xcd < r ? xcd * (q + 1) : r * (q + 1) + (xcd - r) * q) + off; }
        const int nig = WGM * nN, gid = wgid / nig, fm = gid * WGM, gsz = (nM - fm) < WGM ? (nM - fm) : WGM;
        u.pm = fm + ((wgid % nig) % gsz); u.pn = (wgid % nig) / gsz; return true;
    }
    __device__ __forceinline__ void a_ready(const Unit&) const {}
    __device__ __forceinline__ void done(const Unit&) const {}
};

#ifndef EPI_DEPTH
#define EPI_DEPTH 4
#endif
__device__ __forceinline__ u32x4 pack8(const f32x4 a, const f32x4 b) { u32x4 w; w.x = cvtpk(a[0], a[1]); w.y = cvtpk(a[2], a[3]); w.z = cvtpk(b[0], b[1]); w.w = cvtpk(b[2], b[3]); return w; }
__device__ __forceinline__ f32x4 silu4(const f32x4 v) { f32x4 o; o[0] = silu_f(v[0]); o[1] = silu_f(v[1]); o[2] = silu_f(v[2]); o[3] = silu_f(v[3]); return o; }
__device__ __forceinline__ f32x4 sigm4(const f32x4 v) { f32x4 o; o[0] = sigmoid_f(v[0]); o[1] = sigmoid_f(v[1]); o[2] = sigmoid_f(v[2]); o[3] = sigmoid_f(v[3]); return o; }
__device__ __forceinline__ float dot4(const f32x4 a) { return (a[0] * a[0] + a[1] * a[1]) + (a[2] * a[2] + a[3] * a[3]); }
struct EpiInProj {
    static constexpr bool PERM = true, AFTER_DRAIN = false;
    const float* rr; const float* qn; const float* kn; bf16_t *Q, *K, *V, *GA, *GS, *U;
    __device__ __forceinline__ void operator()(const f32x4 (&acc)[2][2][4][2], const Unit& u, int wr, int wc, int fr, int fq) const {
        const int seg = u.pn >> 1, half = u.pn & 1;
        const int row0 = u.pm * BM + wr * 64 + fr;
        const int lc0 = half * 256 + wc * 64 + 8 * fq;
        f32x4 gv[2][2];
#pragma unroll
        for (int bj = 0; bj < 2; ++bj)
#pragma unroll
            for (int n = 0; n < 2; ++n) gv[bj][n] = (f32x4){1.f, 1.f, 1.f, 1.f};
        if (seg < 2) { const float* gp = seg == 0 ? qn : kn; const float sc = seg == 0 ? QSCALE : 1.f;
#pragma unroll
            for (int bj = 0; bj < 2; ++bj)
#pragma unroll
                for (int n = 0; n < 2; ++n) gv[bj][n] = *(const f32x4*)(gp + 32 * bj + 8 * fq + 4 * n) * sc; }
        bf16_t* dst = seg == 0 ? Q : (seg == 1 ? K : (seg == 2 ? V : (seg == 3 ? GA : GS)));
#pragma unroll
        for (int ai = 0; ai < 2; ++ai)
#pragma unroll
            for (int m = 0; m < 4; ++m) {
                const int r = row0 + ai * HALF + m * 16; const float rs = rr[r];
                f32x4 v[2][2];
#pragma unroll
                for (int bj = 0; bj < 2; ++bj)
#pragma unroll
                    for (int n = 0; n < 2; ++n) v[bj][n] = acc[ai][bj][m][n] * rs;
                if (seg < 2) {
                    float ss = (dot4(v[0][0]) + dot4(v[0][1])) + (dot4(v[1][0]) + dot4(v[1][1]));
                    ss = xsum32(xsum16(ss));
                    const float rn = __builtin_amdgcn_rsqf(ss * (1.f / HD) + EPS);
#pragma unroll
                    for (int bj = 0; bj < 2; ++bj)
#pragma unroll
                        for (int n = 0; n < 2; ++n) v[bj][n] = v[bj][n] * rn * gv[bj][n];
                } else if (seg == 3 || seg == 5) {
#pragma unroll
                    for (int bj = 0; bj < 2; ++bj)
#pragma unroll
                        for (int n = 0; n < 2; ++n) v[bj][n] = silu4(v[bj][n]);
                }
#pragma unroll
                for (int bj = 0; bj < 2; ++bj) {
                    const u32x4 w = pack8(v[bj][0], v[bj][1]); const int cc = lc0 + 32 * bj;
                    if (seg == 4) { const int b = r >> 11, s = r & 2047, g = cc >> 4; __builtin_nontemporal_store(w, (u32x4*)(U + ((size_t)(b * NG + g) * SEQ + s) * GC + (cc & 15))); }
                    else if (seg == 3 || seg == 5) __builtin_nontemporal_store(w, (u32x4*)(dst + (size_t)r * AW + cc));
                    else *(u32x4*)(dst + (size_t)r * AW + cc) = w;
                }
            }
    }
};
struct EpiGlu {
    static constexpr bool PERM = true, AFTER_DRAIN = false;
    const float* bglu; const bf16_t* YG; const bf16_t* GS; bf16_t* MIX;
    __device__ __forceinline__ void operator()(const f32x4 (&acc)[2][2][4][2], const Unit& u, int wr, int wc, int fr, int fq) const {
        const int row0 = u.pm * BM + wr * 64 + fr, col0 = u.pn * BM + wc * 32 + 8 * fq;
        f32x4 bv[2][2];
#pragma unroll
        for (int bj = 0; bj < 2; ++bj)
#pragma unroll
            for (int n = 0; n < 2; ++n) bv[bj][n] = *(const f32x4*)(bglu + col0 + bj * HALF + 4 * n);
        u32x4 y8[EPI_DEPTH][2], g8[EPI_DEPTH][2];
#define GLU_ISSUE(g_) do { const int r_ = row0 + ((g_) >> 2) * HALF + ((g_) & 3) * 16; _Pragma("unroll") for (int bj = 0; bj < 2; ++bj) { const int c_ = col0 + bj * HALF; \
            y8[(g_) % EPI_DEPTH][bj] = *(const u32x4*)(YG + (size_t)r_ * AW + c_); g8[(g_) % EPI_DEPTH][bj] = __builtin_nontemporal_load((const u32x4*)(GS + (size_t)r_ * AW + c_)); } } while (0)
#pragma unroll
        for (int g = 0; g < EPI_DEPTH; ++g) GLU_ISSUE(g);
#pragma unroll
        for (int g = 0; g < 8; ++g) { const int ai = g >> 2, m = g & 3, r = row0 + ai * HALF + m * 16;
#pragma unroll
            for (int bj = 0; bj < 2; ++bj) { const int c = col0 + bj * HALF; const u32x4 yv = y8[g % EPI_DEPTH][bj], gv = g8[g % EPI_DEPTH][bj];
                const f32x4 s0 = sigm4(acc[ai][bj][m][0] + bv[bj][0]), s1 = sigm4(acc[ai][bj][m][1] + bv[bj][1]);
                f32x4 o0, o1;
                o0[0] = bflo(yv[0]) * s0[0] * bflo(gv[0]); o0[1] = bfhi(yv[0]) * s0[1] * bfhi(gv[0]); o0[2] = bflo(yv[1]) * s0[2] * bflo(gv[1]); o0[3] = bfhi(yv[1]) * s0[3] * bfhi(gv[1]);
                o1[0] = bflo(yv[2]) * s1[0] * bflo(gv[2]); o1[1] = bfhi(yv[2]) * s1[1] * bfhi(gv[2]); o1[2] = bflo(yv[3]) * s1[2] * bflo(gv[3]); o1[3] = bfhi(yv[3]) * s1[3] * bfhi(gv[3]);
                *(u32x4*)(MIX + (size_t)r * DM + AW + c) = pack8(o0, o1); }
            if (g + EPI_DEPTH < 8) GLU_ISSUE(g + EPI_DEPTH);
            asm volatile("" ::: "memory"); }
#undef GLU_ISSUE
    }
};
struct EpiOut {
    static constexpr bool PERM = true, AFTER_DRAIN = false;
    const bf16_t* xb; bf16_t* HB; float* SSP;
    __device__ __forceinline__ void operator()(const f32x4 (&acc)[2][2][4][2], const Unit& u, int wr, int wc, int fr, int fq) const {
        const int row0 = u.pm * BM + wr * 64 + fr, col0 = u.pn * BM + wc * 32 + 8 * fq;
        u32x4 xv[EPI_DEPTH][2];
#define OUT_ISSUE(g_) do { const int r_ = row0 + ((g_) >> 2) * HALF + ((g_) & 3) * 16; _Pragma("unroll") for (int bj = 0; bj < 2; ++bj) \
            xv[(g_) % EPI_DEPTH][bj] = *(const u32x4*)(xb + (size_t)r_ * DM + col0 + bj * HALF); } while (0)
#pragma unroll
        for (int g = 0; g < EPI_DEPTH; ++g) OUT_ISSUE(g);
#pragma unroll
        for (int g = 0; g < 8; ++g) { const int ai = g >> 2, m = g & 3, r = row0 + ai * HALF + m * 16; float ss = 0.f;
#pragma unroll
            for (int bj = 0; bj < 2; ++bj) { const size_t o = (size_t)r * DM + col0 + bj * HALF; const u32x4 xw = xv[g % EPI_DEPTH][bj];
                const f32x4 h0 = (f32x4){bflo(xw[0]), bfhi(xw[0]), bflo(xw[1]), bfhi(xw[1])} + acc[ai][bj][m][0], h1 = (f32x4){bflo(xw[2]), bfhi(xw[2]), bflo(xw[3]), bfhi(xw[3])} + acc[ai][bj][m][1];
                ss += dot4(h0) + dot4(h1);
                *(u32x4*)(HB + o) = pack8(h0, h1); }
            ss = xsum32(xsum16(ss));
            if (fq == 0) SSP[(size_t)r * 16 + u.pn * 4 + wc] = ss;
            if (g + EPI_DEPTH < 8) OUT_ISSUE(g + EPI_DEPTH);
            asm volatile("" ::: "memory"); }
#undef OUT_ISSUE
    }
};
struct EpiProj {
    static constexpr bool PERM = true, AFTER_DRAIN = false;
    bf16_t* PR;
    __device__ __forceinline__ void operator()(const f32x4 (&acc)[2][2][4][2], const Unit& u, int wr, int wc, int fr, int fq) const {
        const int row0 = u.pm * BM + wr * 64 + fr, col0 = u.pn * BM + wc * 32 + 8 * fq;
#pragma unroll
        for (int ai = 0; ai < 2; ++ai)
#pragma unroll
            for (int m = 0; m < 4; ++m)
#pragma unroll
                for (int bj = 0; bj < 2; ++bj) *(u32x4*)(PR + (size_t)(row0 + ai * HALF + m * 16) * DM + col0 + bj * HALF) = pack8(acc[ai][bj][m][0], acc[ai][bj][m][1]);
    }
};
struct EpiGate {
    static constexpr bool PERM = true, AFTER_DRAIN = false;
    const float* RRH; const bf16_t* PR; const bf16_t* HBr; float* out;
    __device__ __forceinline__ void operator()(const f32x4 (&acc)[2][2][4][2], const Unit& u, int wr, int wc, int fr, int fq) const {
        const int row0 = u.pm * BM + wr * 64 + fr, col0 = u.pn * BM + wc * 32 + 8 * fq;
        float rsv[8];
#pragma unroll
        for (int g = 0; g < 8; ++g) rsv[g] = RRH[row0 + (g >> 2) * HALF + (g & 3) * 16];
        u32x4 p8[EPI_DEPTH][2], h8[EPI_DEPTH][2];
#define GATE_ISSUE(g_) do { const int r_ = row0 + ((g_) >> 2) * HALF + ((g_) & 3) * 16; _Pragma("unroll") for (int bj = 0; bj < 2; ++bj) { const size_t o_ = (size_t)r_ * DM + col0 + bj * HALF; \
            p8[(g_) % EPI_DEPTH][bj] = *(const u32x4*)(PR + o_); h8[(g_) % EPI_DEPTH][bj] = *(const u32x4*)(HBr + o_); } } while (0)
#pragma unroll
        for (int g = 0; g < EPI_DEPTH; ++g) GATE_ISSUE(g);
#pragma unroll
        for (int g = 0; g < 8; ++g) { const int ai = g >> 2, m = g & 3, r = row0 + ai * HALF + m * 16; const float rs = rsv[g];
#pragma unroll
            for (int bj = 0; bj < 2; ++bj) { const size_t o = (size_t)r * DM + col0 + bj * HALF; const u32x4 pv = p8[g % EPI_DEPTH][bj], hv = h8[g % EPI_DEPTH][bj];
                const f32x4 g0 = sigm4(acc[ai][bj][m][0] * rs), g1 = sigm4(acc[ai][bj][m][1] * rs);
                f32x4 o0, o1;
                o0[0] = bflo(hv[0]) + g0[0] * bflo(pv[0]); o0[1] = bfhi(hv[0]) + g0[1] * bfhi(pv[0]); o0[2] = bflo(hv[1]) + g0[2] * bflo(pv[1]); o0[3] = bfhi(hv[1]) + g0[3] * bfhi(pv[1]);
                o1[0] = bflo(hv[2]) + g1[0] * bflo(pv[2]); o1[1] = bfhi(hv[2]) + g1[1] * bfhi(pv[2]); o1[2] = bflo(hv[3]) + g1[2] * bflo(pv[3]); o1[3] = bfhi(hv[3]) + g1[3] * bfhi(pv[3]);
                __builtin_nontemporal_store(o0, (f32x4*)(out + o)); __builtin_nontemporal_store(o1, (f32x4*)(out + o + 4)); }
            if (g + EPI_DEPTH < 8) GATE_ISSUE(g + EPI_DEPTH);
            asm volatile("" ::: "memory"); }
#undef GATE_ISSUE
    }
};
template <class Epi, class Sched, bool ALIGN_EPI = false, bool SP2 = false>
__device__ __forceinline__ void gemm_phase(PG8_LAS unsigned char* lds, const Gemm g, const Sched& S, const Epi& E) {
    const int tid = threadIdx.x, wid = __builtin_amdgcn_readfirstlane(tid >> 6), lane = tid & 63, wr = wid >> 2, wc = wid & 3, fr = lane & 15, fq = lane >> 4;
    const int K = g.K, nt = K / BK;
    unsigned voffA[2], voffB[2];
#pragma unroll
    for (int i = 0; i < 2; ++i) { int R, C; stage_rc(tid * 16 + i * 8192, R, C); const int Rb = Epi::PERM ? ((R & ~31) + perm32(R & 31)) : R;
        voffA[i] = (unsigned)(R * K + C) * 2u; voffB[i] = (unsigned)(Rb * K + C) * 2u; }
    const size_t kstep = (size_t)(BK * 2);
    const size_t hstep = (size_t)HALF * K * 2;
    const size_t tstep = 2 * hstep;
    const unsigned ldsw = (unsigned)wid * 1024u;
    const int aoff = lds_byte(wr * 64 + fr, fq * 8), boff = lds_byte(wc * 32 + fr, fq * 8);
#define PG8_SA(b, h) (((b) * 2 + (h)) * HTB)
#define PG8_SB(b, h) ((4 + (b) * 2 + (h)) * HTB)
#define PG8_STAGE(bufoff, gbase, voff) do { _Pragma("unroll") for (int _i = 0; _i < 2; ++_i) \
        __builtin_amdgcn_global_load_lds((const unsigned*)((const char*)(gbase) + (voff)[_i]), (PG8_LAS unsigned*)(lds + (bufoff) + ldsw + _i * 8192), 16, 0, 0); } while (0)
#define PG8_LDA(dst, b, h) do { _Pragma("unroll") for (int m = 0; m < 4; ++m) _Pragma("unroll") for (int k = 0; k < 2; ++k) dst[m][k] = *(const PG8_LAS bf16x8*)(lds + PG8_SA(b, h) + aoff + m * 2048 + k * 1024); } while (0)
#define PG8_LDB(dst, b, h) do { _Pragma("unroll") for (int n = 0; n < 2; ++n) _Pragma("unroll") for (int k = 0; k < 2; ++k) dst[n][k] = *(const PG8_LAS bf16x8*)(lds + PG8_SB(b, h) + boff + n * 2048 + k * 1024); } while (0)
#define PG8_MMA(ai, bj, At, Bt) do { __builtin_amdgcn_s_setprio(1); _Pragma("unroll") for (int m = 0; m < 4; ++m) _Pragma("unroll") for (int n = 0; n < 2; ++n) _Pragma("unroll") for (int k = 0; k < 2; ++k) \
        acc[ai][bj][m][n] = __builtin_amdgcn_mfma_f32_16x16x32_bf16(Bt[n][k], At[m][k], acc[ai][bj][m][n], 0, 0, 0); __builtin_amdgcn_s_setprio(0); } while (0)
#define PG8_WAIT_V(n) asm volatile("s_waitcnt vmcnt(" #n ")" ::: "memory")
#define PG8_WAIT_L(n) asm volatile("s_waitcnt lgkmcnt(" #n ")" ::: "memory")
#define PG8_BAR __builtin_amdgcn_s_barrier()
#define PG8_SCHED __builtin_amdgcn_sched_barrier(0)
    Unit cur, nxt; int ui = 0;
    if (!S.next(0, cur)) return;
    f32x4 acc[2][2][4][2];
#pragma unroll
    for (int a = 0; a < 2; ++a)
#pragma unroll
        for (int b = 0; b < 2; ++b)
#pragma unroll
            for (int m = 0; m < 4; ++m)
#pragma unroll
                for (int n = 0; n < 2; ++n) acc[a][b][m][n] = (f32x4){0.f, 0.f, 0.f, 0.f};
    bf16x8 At[4][2], B0[2][2], B1[2][2];
    const char* cA = (const char*)g.A + (size_t)cur.pm * tstep; const char* cB = (const char*)g.Bt + (size_t)cur.pn * tstep;
    S.a_ready(cur);
    if constexpr (SP2) {
        PG8_STAGE(PG8_SB(0, 0), cB, voffB); PG8_STAGE(PG8_SB(0, 1), cB + hstep, voffB); PG8_STAGE(PG8_SA(0, 0), cA, voffA); PG8_STAGE(PG8_SA(0, 1), cA + hstep, voffA);
        if (wr == 1) PG8_BAR;
        PG8_WAIT_V(2); PG8_BAR;
        PG8_STAGE(PG8_SB(1, 0), cB + kstep, voffB); PG8_STAGE(PG8_SA(1, 0), cA + kstep, voffA); PG8_STAGE(PG8_SB(1, 1), cB + hstep + kstep, voffB);
        PG8_WAIT_V(6); PG8_BAR;
    } else {
        PG8_STAGE(PG8_SB(0, 0), cB, voffB); PG8_STAGE(PG8_SA(0, 0), cA, voffA); PG8_STAGE(PG8_SB(0, 1), cB + hstep, voffB); PG8_STAGE(PG8_SA(0, 1), cA + hstep, voffA);
        if (wr == 1) PG8_BAR;
        PG8_WAIT_V(4); PG8_BAR;
        PG8_STAGE(PG8_SB(1, 0), cB + kstep, voffB); PG8_STAGE(PG8_SA(1, 0), cA + kstep, voffA); PG8_STAGE(PG8_SB(1, 1), cB + hstep + kstep, voffB);
        PG8_WAIT_V(6); PG8_BAR;
    }
    for (;;) {
        const bool has_next = S.next(ui + 1, nxt);
        const char* nA = has_next ? (const char*)g.A + (size_t)nxt.pm * tstep : cA; const char* nB = has_next ? (const char*)g.Bt + (size_t)nxt.pn * tstep : cB;
#pragma nounroll
        for (int t = 0; t < nt; t += 2) {
            const bool last = (t == nt - 2);
            const char* a1 = cA + (size_t)(t + 1) * kstep;
            const char* a2 = last ? nA : cA + (size_t)(t + 2) * kstep; const char* b2 = last ? nB : cB + (size_t)(t + 2) * kstep;
            const char* a3 = a2 + kstep; const char* b3 = b2 + kstep;
            if (last && has_next) S.a_ready(nxt);
            if constexpr (SP2) {
            PG8_LDB(B0, 0, 0); PG8_LDB(B1, 0, 1); PG8_SCHED; PG8_LDA(At, 0, 0); PG8_STAGE(PG8_SA(1, 1), a1 + hstep, voffA);
            PG8_WAIT_V(8); PG8_WAIT_L(0); PG8_BAR; PG8_MMA(0, 0, At, B0); PG8_MMA(0, 1, At, B1); PG8_BAR; PG8_SCHED;
            PG8_LDA(At, 0, 1); PG8_STAGE(PG8_SB(0, 0), b2, voffB); PG8_STAGE(PG8_SB(0, 1), b2 + hstep, voffB); PG8_STAGE(PG8_SA(0, 0), a2, voffA);
            PG8_WAIT_V(8); PG8_WAIT_L(0); PG8_BAR; PG8_MMA(1, 0, At, B0); PG8_MMA(1, 1, At, B1); PG8_BAR; PG8_SCHED;
            PG8_LDB(B0, 1, 0); PG8_LDB(B1, 1, 1); PG8_SCHED; PG8_LDA(At, 1, 0); PG8_STAGE(PG8_SA(0, 1), a2 + hstep, voffA);
            PG8_WAIT_V(8); PG8_WAIT_L(0); PG8_BAR; PG8_MMA(0, 0, At, B0); PG8_MMA(0, 1, At, B1); PG8_BAR; PG8_SCHED;
            PG8_LDA(At, 1, 1); PG8_STAGE(PG8_SB(1, 0), b3, voffB); PG8_STAGE(PG8_SB(1, 1), b3 + hstep, voffB); PG8_STAGE(PG8_SA(1, 0), a3, voffA);
            PG8_WAIT_V(8); PG8_WAIT_L(0); PG8_BAR; PG8_MMA(1, 0, At, B0); PG8_MMA(1, 1, At, B1); PG8_BAR; PG8_SCHED;
            } else {
            PG8_LDB(B0, 0, 0); PG8_SCHED; PG8_LDA(At, 0, 0); PG8_STAGE(PG8_SA(1, 1), a1 + hstep, voffA);
            PG8_WAIT_L(8); PG8_BAR; PG8_WAIT_L(0); PG8_MMA(0, 0, At, B0); PG8_BAR; PG8_SCHED;
            PG8_LDB(B1, 0, 1); PG8_STAGE(PG8_SB(0, 0), b2, voffB);
            PG8_BAR; PG8_WAIT_L(0); PG8_MMA(0, 1, At, B1); PG8_BAR;
            PG8_LDA(At, 0, 1); PG8_STAGE(PG8_SA(0, 0), a2, voffA);
            PG8_BAR; PG8_WAIT_L(0); PG8_MMA(1, 0, At, B0); PG8_BAR; PG8_SCHED;
            PG8_STAGE(PG8_SB(0, 1), b2 + hstep, voffB);
            PG8_WAIT_V(6); PG8_BAR; PG8_MMA(1, 1, At, B1); PG8_BAR;
            PG8_LDB(B0, 1, 0); PG8_SCHED; PG8_LDA(At, 1, 0); PG8_STAGE(PG8_SA(0, 1), a2 + hstep, voffA);
            PG8_WAIT_L(8); PG8_BAR; PG8_WAIT_L(0); PG8_MMA(0, 0, At, B0); PG8_BAR; PG8_SCHED;
            PG8_LDB(B1, 1, 1); PG8_STAGE(PG8_SB(1, 0), b3, voffB);
            PG8_BAR; PG8_WAIT_L(0); PG8_MMA(0, 1, At, B1); PG8_BAR;
            PG8_LDA(At, 1, 1); PG8_STAGE(PG8_SA(1, 0), a3, voffA);
            PG8_BAR; PG8_WAIT_L(0); PG8_MMA(1, 0, At, B0); PG8_BAR; PG8_SCHED;
            PG8_STAGE(PG8_SB(1, 1), b3 + hstep, voffB);
            PG8_WAIT_V(6); PG8_BAR; PG8_MMA(1, 1, At, B1); PG8_BAR;
            }
        }
        if constexpr (ALIGN_EPI) { if (wr == 0) PG8_BAR; }
        if constexpr (!Epi::AFTER_DRAIN) { E(acc, cur, wr, wc, fr, fq); S.done(cur); }
        if (!has_next) break;
#pragma unroll
        for (int a = 0; a < 2; ++a)
#pragma unroll
            for (int b = 0; b < 2; ++b)
#pragma unroll
                for (int m = 0; m < 4; ++m)
#pragma unroll
                    for (int n = 0; n < 2; ++n) acc[a][b][m][n] = (f32x4){0.f, 0.f, 0.f, 0.f};
        cur = nxt; cA = nA; cB = nB; ++ui;
        if constexpr (ALIGN_EPI) { if (wr == 1) PG8_BAR; }
    }
    PG8_WAIT_V(0);
    if constexpr (!ALIGN_EPI) { if (wr == 0) PG8_BAR; }
    PG8_BAR;
    if constexpr (Epi::AFTER_DRAIN) { E.fused(acc, cur, wr, wc, fr, fq, lds, wid, lane); S.done(cur); }
#undef PG8_SA
#undef PG8_SB
#undef PG8_STAGE
#undef PG8_LDA
#undef PG8_LDB
#undef PG8_MMA
#undef PG8_WAIT_V
#undef PG8_WAIT_L
#undef PG8_BAR
#undef PG8_SCHED
}
}
template <bool PERMCOL>
__device__ __forceinline__ void transpose_item(const float* W, int K, int N, bf16_t* WT, const float* ksc, LAS float* scr, int item, int lane) {
    const int nblk = N / 32, kb = item / nblk, nb = item % nblk, k0 = 64 * kb, n0 = 32 * nb;
    const int src0 = PERMCOL ? pi_col(n0) : n0;
    float tv[32];
#pragma unroll
    for (int i = 0; i < 32; ++i) { const int kk = 2 * i + (lane >> 5); tv[i] = __builtin_nontemporal_load(W + (size_t)(k0 + kk) * N + src0 + (lane & 31)); }
#pragma unroll
    for (int i = 0; i < 32; ++i) { const int kk = 2 * i + (lane >> 5); scr[kk * 33 + (lane & 31)] = tv[i] * (ksc ? ksc[k0 + kk] : 1.f); }
    asm volatile("s_waitcnt lgkmcnt(0)" ::: "memory");
    const int c8 = lane & 7;
#pragma unroll
    for (int j = 0; j < 4; ++j) { const int n = (lane >> 3) + 8 * j; const LAS float* s = scr + (8 * c8) * 33 + n;
        u32x4 o; o.x = cvtpk(s[0 * 33], s[1 * 33]); o.y = cvtpk(s[2 * 33], s[3 * 33]); o.z = cvtpk(s[4 * 33], s[5 * 33]); o.w = cvtpk(s[6 * 33], s[7 * 33]);
        *(u32x4*)(WT + (size_t)(n0 + n) * K + k0 + 8 * c8) = o; }
    asm volatile("s_waitcnt lgkmcnt(0)" ::: "memory");
}
__device__ __forceinline__ void ph_prep(const Params& P, const Ctx& c, LAS unsigned char* lds) {
    unsigned char* ws = P.ws;
    LAS float* scr = (LAS float*)(lds + (threadIdx.x >> 6) * 8704);
    constexpr int I_IN = (DM / 64) * (INW / 32);
    for (int it = c.gwave; it < I_IN; it += c.nwaves) transpose_item<true>(P.in[3], DM, INW, (bf16_t*)(ws + WS_WINT), P.in[2], scr, it, c.lane);
    const float* x = P.in[0]; bf16_t* XB = (bf16_t*)(ws + WS_XB); float* rr = (float*)(ws + WS_RRMSX);
    const bool stag = gridDim.x == 256;
    for (int idx0 = c.gwave * 8; idx0 < (stag ? T / 2 : T); idx0 += c.nwaves * 8) {
        const int row0 = stag ? ((((idx0 >> 11) * 16 + ((idx0 >> 8) & 7)) << 8) + (idx0 & 255)) : idx0;
        f32x4 v[8][4];
#pragma unroll
        for (int q = 0; q < 8; ++q) { const f32x4* xr = (const f32x4*)(x + (size_t)(row0 + q) * DM) + c.lane;
#pragma unroll
            for (int j = 0; j < 4; ++j) v[q][j] = __builtin_nontemporal_load(xr + 64 * j); }
#pragma unroll
        for (int q = 0; q < 8; ++q) {
            float s = 0.f;
#pragma unroll
            for (int j = 0; j < 4; ++j) s += (v[q][j].x * v[q][j].x + v[q][j].y * v[q][j].y) + (v[q][j].z * v[q][j].z + v[q][j].w * v[q][j].w);
            s = wave_sum(s);
            if (c.lane == 0) rr[row0 + q] = 1.0f / sqrtf(s * (1.f / DM) + EPS);
            unsigned long long* o8 = (unsigned long long*)(XB + (size_t)(row0 + q) * DM) + c.lane;
#pragma unroll
            for (int j = 0; j < 4; ++j) o8[64 * j] = (unsigned long long)cvtpk(v[q][j].x, v[q][j].y) | ((unsigned long long)cvtpk(v[q][j].z, v[q][j].w) << 32);
        }
    }
}
__device__ __forceinline__ void st8_wt(void* p, unsigned long long v) { asm volatile("global_store_dwordx2 %0, %1, off sc0 sc1" :: "v"(p), "v"(v) : "memory"); }
__device__ __forceinline__ void st4_wt(void* p, float v) { asm volatile("global_store_dword %0, %1, off sc0 sc1" :: "v"(p), "v"(v) : "memory"); }
__device__ __forceinline__ void convert_rows_wt(const float* __restrict__ x, bf16_t* XB, float* rr, int row0, int lane) {
#pragma unroll 1
    for (int h = 0; h < 2; ++h) {
        f32x4 v[4][4];
#pragma unroll
        for (int q = 0; q < 4; ++q) { const f32x4* xr = (const f32x4*)(x + (size_t)(row0 + 4 * h + q) * DM) + lane;
#pragma unroll
            for (int j = 0; j < 4; ++j) v[q][j] = __builtin_nontemporal_load(xr + 64 * j); }
#pragma unroll
        for (int q = 0; q < 4; ++q) {
            float s = 0.f;
#pragma unroll
            for (int j = 0; j < 4; ++j) s += (v[q][j].x * v[q][j].x + v[q][j].y * v[q][j].y) + (v[q][j].z * v[q][j].z + v[q][j].w * v[q][j].w);
            s = wave_sum(s);
            if (lane == 0) st4_wt(rr + row0 + 4 * h + q, 1.0f / sqrtf(s * (1.f / DM) + EPS));
            unsigned long long* o8 = (unsigned long long*)(XB + (size_t)(row0 + 4 * h + q) * DM) + lane;
#pragma unroll
            for (int j = 0; j < 4; ++j) st8_wt(o8 + 64 * j, (unsigned long long)cvtpk(v[q][j].x, v[q][j].y) | ((unsigned long long)cvtpk(v[q][j].z, v[q][j].w) << 32));
        }
    }
    asm volatile("s_waitcnt vmcnt(0)" ::: "memory");
}
__device__ __forceinline__ void ph_prep_late(const Params& P, const Ctx& c, LAS unsigned char* lds, const int part) {
    unsigned char* ws = P.ws;
    LAS float* scr = (LAS float*)(lds + (threadIdx.x >> 6) * 8704);
    constexpr int I_GLU = (AW / 64) * (AW / 32), I_SQ = (DM / 64) * (DM / 32), I_P = (PLE / 64) * (DM / 32);
    const int lo_it = part == 0 ? 0 : 2 * I_SQ, hi_it = part == 0 ? 2 * I_SQ : I_GLU + 2 * I_SQ + I_P;
    for (int it = lo_it + c.gwave; it < hi_it; it += c.nwaves) {
        int r = it;
        if (r < I_SQ) { transpose_item<false>(P.in[16], DM, DM, (bf16_t*)(ws + WS_WOUTT), nullptr, scr, r, c.lane); continue; } r -= I_SQ;
        if (r < I_SQ) { transpose_item<false>(P.in[18], DM, DM, (bf16_t*)(ws + WS_WGT), P.in[17], scr, r, c.lane); continue; } r -= I_SQ;
        if (r < I_GLU) { transpose_item<false>(P.in[14], AW, AW, (bf16_t*)(ws + WS_WGLUT), nullptr, scr, r, c.lane); continue; } r -= I_GLU;
        transpose_item<false>(P.in[19], PLE, DM, (bf16_t*)(ws + WS_WPT), nullptr, scr, r, c.lane);
    }
}
__device__ __forceinline__ void ph_prep_p(const Params& P, const Ctx& c) {
    unsigned char* ws = P.ws;
    const float* p = P.in[1]; bf16_t* PB = (bf16_t*)(ws + WS_PB);
    constexpr size_t NV = (size_t)T * PLE / 4;
    for (size_t i = c.gtid; i < NV / 16; i += c.nthr) {
        f32x4 v[16];
#pragma unroll
        for (int q = 0; q < 16; ++q) v[q] = __builtin_nontemporal_load((const f32x4*)p + i + (size_t)q * (NV / 16));
#pragma unroll
        for (int q = 0; q < 16; ++q) ((unsigned long long*)PB)[i + (size_t)q * (NV / 16)] = (unsigned long long)cvtpk(v[q].x, v[q].y) | ((unsigned long long)cvtpk(v[q].z, v[q].w) << 32);
    }
}
__device__ __forceinline__ void ph_attn_naive(const Params& P, const Ctx& c) {
    unsigned char* ws = P.ws;
    const bf16_t* Q = (const bf16_t*)(ws + WS_Q); const bf16_t* K = (const bf16_t*)(ws + WS_K); const bf16_t* V = (const bf16_t*)(ws + WS_V);
    bf16_t* NUM = (bf16_t*)(ws + WS_NUM); float* DEN = (float*)(ws + WS_DEN);
    for (int it = c.gwave; it < 3 * T * NH; it += c.nwaves) {
        const int h = it & 7, rc = it >> 3, row = rc % T, cf = rc / T;
        const int dil = cf == 0 ? 1 : (cf == 1 ? 4 : 16);
        const int s = row & 2047; const size_t rb = (size_t)(row - s);
        const float q = bf2f(Q[(size_t)row * AW + h * HD + c.lane]);
        float acc = 0.f, den = 0.f;
        for (int j = 0; j <= 128; ++j) {
            const int ks = s - j * dil; if (ks < 0) break;
            const size_t off = (rb + ks) * AW + h * HD + c.lane;
            const float sc = wave_sum(q * bf2f(K[off]));
            const float p = exp2f(sc); den += p; acc += p * bf2f(V[off]);
        }
        NUM[((size_t)cf * T + row) * AW + h * HD + c.lane] = (bf16_t)f2bf(acc);
        if (c.lane == 0) DEN[((size_t)cf * T + row) * NH + h] = den;
    }
}
__device__ __forceinline__ void ph_ssm_naive(const Params& P, const Ctx& c) {
    unsigned char* ws = P.ws;
    const float* lam_re = P.in[6]; const float* lam_im = P.in[7]; const float* log_dt = P.in[8];
    const float* b_re = P.in[9]; const float* b_im = P.in[10]; const float* c_re = P.in[11]; const float* c_im = P.in[12]; const float* d_skip = P.in[13];
    const bf16_t* U = (const bf16_t*)(ws + WS_U); bf16_t* YG = (bf16_t*)(ws + WS_YG);
    for (int it = c.gwave; it < NB * NG; it += c.nwaves) {
        const int b = it / NG, g = it % NG, n = c.lane;
        const float dt = expf(log_dt[g]), lr = lam_re[g * NS + n], li = lam_im[g * NS + n];
        const float mag = expf(lr * dt); float sn, cs; sincosf(li * dt, &sn, &cs);
        const float ar = mag * cs, ai = mag * sn;
        const float dn = lr * lr + li * li, nr = ar - 1.f;
        const float cr = (nr * lr + ai * li) / dn, ci = (ai * lr - nr * li) / dn;
        float bbr[16], bbi[16], cre[16], cim[16];
#pragma unroll
        for (int ch = 0; ch < 16; ++ch) { const float br = b_re[(size_t)(g * NS + n) * GC + ch], bi = b_im[(size_t)(g * NS + n) * GC + ch];
            bbr[ch] = cr * br - ci * bi; bbi[ch] = cr * bi + ci * br; cre[ch] = c_re[(size_t)(g * GC + ch) * NS + n]; cim[ch] = c_im[(size_t)(g * GC + ch) * NS + n]; }
        const float dsk = d_skip[g * GC + (c.lane & 15)];
        float xr = 0.f, xi = 0.f;
        const bf16_t* up = U + (size_t)(b * NG + g) * SEQ * GC;
        for (int s = 0; s < SEQ; ++s) {
            const u32x4 w0 = *(const u32x4*)(up + (size_t)s * GC), w1 = *(const u32x4*)(up + (size_t)s * GC + 8);
            float uu[16];
#pragma unroll
            for (int j = 0; j < 4; ++j) { uu[2 * j] = bflo(w0[j]); uu[2 * j + 1] = bfhi(w0[j]); uu[8 + 2 * j] = bflo(w1[j]); uu[8 + 2 * j + 1] = bfhi(w1[j]); }
            float bur = 0.f, bui = 0.f;
#pragma unroll
            for (int ch = 0; ch < 16; ++ch) { bur += uu[ch] * bbr[ch]; bui += uu[ch] * bbi[ch]; }
            const float nxr = ar * xr - ai * xi + bur, nxi = ar * xi + ai * xr + bui; xr = nxr; xi = nxi;
            float myy = 0.f, myu = 0.f;
#pragma unroll
            for (int ch = 0; ch < 16; ++ch) { const float tsum = wave_sum(xr * cre[ch] - xi * cim[ch]); if (c.lane == ch) { myy = tsum; myu = uu[ch]; } }
            if (c.lane < 16) { const float y = myy + dsk * myu; const float yg = 0.5f * y * (1.f + erff(y * 0.70710678118654752f));
                YG[(size_t)(b * SEQ + s) * AW + g * GC + c.lane] = (bf16_t)f2bf(yg); }
        }
    }
}
typedef short v4i16_t __attribute__((ext_vector_type(4)));
typedef float f32x16 __attribute__((ext_vector_type(16)));
namespace att {
constexpr int KSTR = 144;
constexpr int NROW = 384, LDS_V = NROW * KSTR, LDS_O = 2 * NROW * KSTR, NUNIT = NB * NH * 24;
struct Desc { int cfg, b, h, cls, jb; };
struct Stage { u32x4 k[6], v[6]; bf16x8 q[4]; };
__device__ __forceinline__ Desc decode(int n) {
    Desc d; d.h = n & 7; const int u = n >> 3, loc = u % 24, idx = loc & 7; d.b = u / 24; d.cfg = loc >> 3;
    d.cls = d.cfg == 0 ? 0 : (d.cfg == 1 ? (idx >> 1) : 2 * idx); d.jb = d.cfg == 0 ? idx : (d.cfg == 1 ? (idx & 1) : 0); return d;
}
__device__ __forceinline__ v4i16_t vtr(LAS const unsigned char* p) { return __builtin_amdgcn_ds_read_tr16_b64_v4i16((LAS v4i16_t*)p); }
__device__ __forceinline__ int strip_of(const Desc& d, int w) { return (d.cfg == 2 && w >= 4) ? 11 - w : w; }
__device__ __forceinline__ int first_tile(const Desc& d, int s) { return d.cfg == 2 ? 4 - (s & 3) : (d.jb == 0 && s < 4 ? 4 - s : 0); }
__device__ __forceinline__ size_t qrow_of(const Desc& d, int s, int ql) {
    const int cls = d.cfg == 2 ? d.cls + (s >> 2) : d.cls, pos = d.cfg == 2 ? 32 * (s & 3) + ql : 256 * d.jb + 32 * s + ql;
    return (size_t)d.b * SEQ + (size_t)pos * (1 << (2 * d.cfg)) + cls;
}
__device__ __forceinline__ void stage_load(Stage& S, const Desc& d, const bf16_t* __restrict__ Q, const bf16_t* __restrict__ K, const bf16_t* __restrict__ V, int tid, int w, int lane) {
    const int dil = 1 << (2 * d.cfg); const size_t rowb = (size_t)d.b * SEQ;
#pragma unroll
    for (int it = 0; it < 6; ++it) {
        const int idx = tid + it * 512, key = idx >> 3, ch = idx & 7;
        const bool valid = it >= 2 || (d.cfg != 2 && d.jb > 0);
        const int cls = d.cls + ((d.cfg == 2 && it >= 4) ? 1 : 0), pos = d.cfg == 2 ? (key & 127) : 256 * d.jb - 128 + key;
        S.k[it] = (u32x4){0u, 0u, 0u, 0u}; S.v[it] = (u32x4){0u, 0u, 0u, 0u};
        if (valid) { const size_t off = (rowb + (size_t)pos * dil + cls) * AW + d.h * HD + ch * 8; S.k[it] = *(const u32x4*)(K + off); S.v[it] = *(const u32x4*)(V + off); }
    }
    const size_t qrow = qrow_of(d, strip_of(d, w), lane & 31);
#pragma unroll
    for (int ks = 0; ks < 4; ++ks) S.q[ks] = *(const bf16x8*)(Q + qrow * AW + d.h * HD + 16 * ks + 8 * (lane >> 5));
}
__device__ __forceinline__ void stage_write(const Stage& S, LAS unsigned char* buf, int tid) {
#pragma unroll
    for (int it = 0; it < 6; ++it) { const int idx = tid + it * 512, key = idx >> 3, ch = idx & 7;
        *(LAS u32x4*)(buf + key * KSTR + ch * 16) = S.k[it]; *(LAS u32x4*)(buf + LDS_V + key * KSTR + ch * 16) = S.v[it]; }
}
#define ATT_A(t_) { f32x16 a_; _Pragma("unroll") for (int r = 0; r < 16; ++r) a_[r] = 0.f; \
    _Pragma("unroll") for (int ks = 0; ks < 4; ++ks) { const bf16x8 kf = *(LAS const bf16x8*)(kb + 32 * (t_) * KSTR + 32 * ks); a_ = __builtin_amdgcn_mfma_f32_32x32x16_bf16(kf, qf[ks], a_, 0, 0, 0); } \
    sc[t_] = a_; }
#define ATT_B(t_) { _Pragma("unroll") for (int r = 0; r < 16; r += 2) { \
        const int kl = (r & 3) + 8 * (r >> 2) + 4 * half; bool v0 = true, v1 = true; \
        if ((t_) == 0) { v0 = kl >= ql; v1 = kl + 1 >= ql; } if ((t_) == 4) { v0 = kl <= ql; v1 = kl + 1 <= ql; } \
        f32x2_t p2; p2.x = v0 ? __builtin_amdgcn_exp2f(sc[t_][r]) : 0.f; p2.y = v1 ? __builtin_amdgcn_exp2f(sc[t_][r + 1]) : 0.f; \
        den2 += p2; pk[t_][r >> 3][(r >> 1) & 3] = cvtpk(p2.x, p2.y); } }
#define ATT_C(t_) { _Pragma("unroll") for (int k2 = 0; k2 < 2; ++k2) { const bf16x8 pf = __builtin_bit_cast(bf16x8, pk[t_][k2]); \
        _Pragma("unroll") for (int db = 0; db < 2; ++db) { \
            const v4i16_t lo = vtr(vb + (32 * (t_) + 16 * k2) * KSTR + 64 * db), hi = vtr(vb + (32 * (t_) + 16 * k2 + 8) * KSTR + 64 * db); \
            const bf16x8 vf = (bf16x8){lo[0], lo[1], lo[2], lo[3], hi[0], hi[1], hi[2], hi[3]}; \
            o[db] = __builtin_amdgcn_mfma_f32_32x32x16_bf16(vf, pf, o[db], 0, 0, 0); } } }
template <int T0>
__device__ __forceinline__ void compute_t(const Desc& d, const bf16x8 (&qf)[4], LAS const unsigned char* buf, bf16_t* NUM, float* DEN, int s, int w, int lane) {
    const int ql = lane & 31, half = lane >> 5, i16 = lane & 15, dh = (lane >> 4) & 1;
    LAS const unsigned char* kb = buf + (32 * s + ql) * KSTR + 16 * half;
    LAS const unsigned char* vb = buf + LDS_V + (32 * s + 4 * half + (i16 >> 2)) * KSTR + 8 * (i16 & 3) + 32 * dh;
    f32x16 sc[5]; u32x4 pk[5][2]; f32x2_t den2 = (f32x2_t){0.f, 0.f}; f32x16 o[2];
#pragma unroll
    for (int db = 0; db < 2; ++db)
#pragma unroll
        for (int r = 0; r < 16; ++r) o[db][r] = 0.f;
    ATT_A(T0)
    if (T0 + 1 <= 4) ATT_A(T0 + 1 <= 4 ? T0 + 1 : 4)
    ATT_B(T0)
    __builtin_amdgcn_sched_barrier(0);
#pragma unroll
    for (int k = T0 + 1; k <= 4; ++k) {
        if (k + 1 <= 4) ATT_A(k + 1 <= 4 ? k + 1 : 4)
        ATT_C(k - 1)
        ATT_B(k)
        __builtin_amdgcn_sched_barrier(0);
    }
    ATT_C(4)
    const float den = xsum32(den2.x + den2.y);
    LAS unsigned char* ob = (LAS unsigned char*)buf + LDS_O + w * (32 * KSTR);
#pragma unroll
    for (int db = 0; db < 2; ++db)
#pragma unroll
        for (int rg = 0; rg < 4; ++rg) {
            const unsigned long long v = (unsigned long long)cvtpk(o[db][4 * rg], o[db][4 * rg + 1]) | ((unsigned long long)cvtpk(o[db][4 * rg + 2], o[db][4 * rg + 3]) << 32);
            *(LAS unsigned long long*)(ob + ql * KSTR + 64 * db + 16 * rg + 8 * half) = v;
        }
#pragma unroll
    for (int i = 0; i < 4; ++i) {
        const int qr = (lane >> 3) + 8 * i; const u32x4 v = *(LAS const u32x4*)(ob + qr * KSTR + 16 * (lane & 7));
        *(u32x4*)(NUM + ((size_t)d.cfg * T + qrow_of(d, s, qr)) * AW + d.h * HD + 8 * (lane & 7)) = v;
    }
    const size_t qrow = qrow_of(d, s, ql);
    if (half == 0) DEN[((size_t)d.cfg * T + qrow) * NH + d.h] = den;
}
__device__ __forceinline__ void compute(const Desc& d, const bf16x8 (&qf)[4], LAS const unsigned char* buf, bf16_t* NUM, float* DEN, int w, int lane) {
    const int s = strip_of(d, w), t0 = first_tile(d, s);
    switch (t0) {
        case 0: compute_t<0>(d, qf, buf, NUM, DEN, s, w, lane); break;
        case 1: compute_t<1>(d, qf, buf, NUM, DEN, s, w, lane); break;
        case 2: compute_t<2>(d, qf, buf, NUM, DEN, s, w, lane); break;
        case 3: compute_t<3>(d, qf, buf, NUM, DEN, s, w, lane); break;
        default: compute_t<4>(d, qf, buf, NUM, DEN, s, w, lane); break;
    }
}
}
#define ATT_BAR() asm volatile("s_waitcnt lgkmcnt(0)\n\ts_barrier" ::: "memory")
__device__ __forceinline__ void ph_attn(const Params& P, LAS unsigned char* lds) {
    unsigned char* ws = P.ws;
    const bf16_t* Q = (const bf16_t*)(ws + WS_Q); const bf16_t* K = (const bf16_t*)(ws + WS_K); const bf16_t* V = (const bf16_t*)(ws + WS_V);
    bf16_t* NUM = (bf16_t*)(ws + WS_NUM); float* DEN = (float*)(ws + WS_DEN);
    const int tid = threadIdx.x, lane = tid & 63, w = __builtin_amdgcn_readfirstlane(tid >> 6);
    int n = (int)blockIdx.x; const int G = (int)gridDim.x;
    if (n < att::NUNIT) {
        att::Desc cur = att::decode(n); att::Stage S; bf16x8 qf[4];
        att::stage_load(S, cur, Q, K, V, tid, w, lane); att::stage_write(S, lds, tid);
#pragma unroll
        for (int ks = 0; ks < 4; ++ks) qf[ks] = S.q[ks];
        wg_sync();
        for (;;) {
            const int nn = n + G; const bool has = nn < att::NUNIT; att::Desc nxt = cur;
            if (has) { nxt = att::decode(nn); att::stage_load(S, nxt, Q, K, V, tid, w, lane); }
            att::compute(cur, qf, lds, NUM, DEN, w, lane);
            if (!has) break;
            ATT_BAR();
            att::stage_write(S, lds, tid);
#pragma unroll
            for (int ks = 0; ks < 4; ++ks) qf[ks] = S.q[ks];
            ATT_BAR();
            cur = nxt; n = nn;
        }
    }
    wg_sync();
}
#define XB_TMO      128
#define XB_XCNT(j)  (256  + 64 * (j))
#define XB_XSUB(j)  (1280 + 64 * (j))
#define XB_XGEN(j)  (2304 + 64 * (j))
#define XB_TOP      3328
#define XB_TOPGEN   3392
#define XCD_BAR_WORDS 3456
#define XB_SPIN_CAP (1u << 18)


__device__ __forceinline__ unsigned xb_ld(unsigned* p)              { return __hip_atomic_load(p, __ATOMIC_RELAXED, __HIP_MEMORY_SCOPE_AGENT); }
__device__ __forceinline__ unsigned xb_add(unsigned* p, unsigned v) { return __hip_atomic_fetch_add(p, v, __ATOMIC_RELAXED, __HIP_MEMORY_SCOPE_AGENT); }
__device__ __forceinline__ unsigned xb_xcc_id() { return (unsigned)__builtin_amdgcn_s_getreg((3 << 11) | 20) & 0xFu; }
#define XB_SPIN(cond, bar) do { unsigned _sp = 0; while (cond) { __builtin_amdgcn_s_sleep(1); \
    if ((++_sp & 255u) == 0u) { if (xb_ld(&(bar)[XB_TMO])) break; if (_sp > XB_SPIN_CAP) { atomicAdd(&(bar)[XB_TMO], 1u); break; } } } } while (0)

struct XcdBarrier {
    unsigned* bar; unsigned x;
    volatile LAS unsigned* st;
};

__device__ __forceinline__ XcdBarrier xcd_barrier_post(unsigned* bar, volatile LAS unsigned* st) {
    XcdBarrier b; b.bar = bar; b.x = xb_xcc_id(); b.st = st;
    if (threadIdx.x == 0) (void)xb_add(&bar[XB_XCNT(b.x)], 1u);
    return b;
}
__device__ __forceinline__ void xcd_barrier_complete(unsigned* bar, unsigned x, unsigned& nloc, unsigned& nx) {
    const unsigned G = gridDim.x * gridDim.y * gridDim.z;
    unsigned sum, cnt, mine, sp = 0u;
    for (;;) {
        sum = 0u; cnt = 0u; mine = 0u;
#pragma unroll
        for (unsigned j = 0; j < 16; ++j) { const unsigned c = xb_ld(&bar[XB_XCNT(j)]); sum += c; cnt += (c > 0u) ? 1u : 0u; mine = (j == x) ? c : mine; }
        if (sum == G) break;
        __builtin_amdgcn_s_sleep(1);
        if ((++sp & 255u) == 0u) { if (xb_ld(&bar[XB_TMO])) break; if (sp > XB_SPIN_CAP) { atomicAdd(&bar[XB_TMO], 1u); break; } }
    }
    nloc = mine > 0u ? mine : 1u; nx = cnt > 0u ? cnt : 1u;
}

__device__ __forceinline__ void xcd_barrier(const XcdBarrier& b) {
    asm volatile("s_waitcnt vmcnt(0)" ::: "memory");
    wg_sync();
    if (threadIdx.x == 0) {
        unsigned* bar = b.bar;
        __builtin_amdgcn_s_waitcnt(0);
        unsigned nloc = b.st[0], nx = b.st[1];
        if (nloc == 0u) { xcd_barrier_complete(bar, b.x, nloc, nx); b.st[0] = nloc; b.st[1] = nx; }
        const unsigned old = xb_add(&bar[XB_XSUB(b.x)], 1u);
        const unsigned gen = old / nloc;
        if (old + 1u == (gen + 1u) * nloc) {
            __builtin_amdgcn_fence(__ATOMIC_RELEASE, "agent");
            asm volatile("s_waitcnt vmcnt(0)" ::: "memory");
            const unsigned og = xb_add(&bar[XB_TOP], 1u);
            const unsigned tg = og / nx;
            if (og + 1u == (tg + 1u) * nx) xb_add(&bar[XB_TOPGEN], 1u);
            else XB_SPIN(xb_ld(&bar[XB_TOPGEN]) == tg, bar);
            __builtin_amdgcn_fence(__ATOMIC_ACQUIRE, "agent");
            xb_add(&bar[XB_XGEN(b.x)], 1u);
            asm volatile("s_waitcnt vmcnt(0)" ::: "memory");
        } else {
            XB_SPIN(xb_ld(&bar[XB_XGEN(b.x)]) == gen, bar);
            __builtin_amdgcn_fence(__ATOMIC_ACQUIRE, "agent");
            asm volatile("s_waitcnt vmcnt(0)" ::: "memory");
        }
    }
    wg_sync();
}

__device__ __forceinline__ void xcd_arrive(const XcdBarrier& b) {
    asm volatile("s_waitcnt vmcnt(0)" ::: "memory");
    wg_sync();
    if (threadIdx.x == 0) {
        unsigned* bar = b.bar;
        __builtin_amdgcn_s_waitcnt(0);
        unsigned nloc = b.st[0], nx = b.st[1];
        if (nloc == 0u) { xcd_barrier_complete(bar, b.x, nloc, nx); b.st[0] = nloc; b.st[1] = nx; }
        const unsigned old = xb_add(&bar[XB_XSUB(b.x)], 1u);
        const unsigned gen = old / nloc;
        if (old + 1u == (gen + 1u) * nloc) {
            __builtin_amdgcn_fence(__ATOMIC_RELEASE, "agent");
            asm volatile("s_waitcnt vmcnt(0)" ::: "memory");
            const unsigned og = xb_add(&bar[XB_TOP], 1u);
            const unsigned tg = og / nx;
            if (og + 1u == (tg + 1u) * nx) xb_add(&bar[XB_TOPGEN], 1u);
            xb_add(&bar[XB_XGEN(b.x)], 1u);
        }
        b.st[2] = gen;
    }
}
__device__ __forceinline__ void xcd_wait(const XcdBarrier& b) {
    if (threadIdx.x == 0) {
        unsigned* bar = b.bar; const unsigned gen = b.st[2];
        XB_SPIN(xb_ld(&bar[XB_TOPGEN]) == gen, bar);
        __builtin_amdgcn_fence(__ATOMIC_ACQUIRE, "agent");
        asm volatile("s_waitcnt vmcnt(0)" ::: "memory");
    }
    wg_sync();
}

__device__ __forceinline__ void xcd_wait_wave(unsigned* bar, volatile LAS unsigned* st, int lane) {
    if (lane == 0) { const unsigned gen = st[2]; XB_SPIN(xb_ld(&bar[XB_TOPGEN]) == gen, bar); }
    __builtin_amdgcn_fence(__ATOMIC_ACQUIRE, "agent");
    asm volatile("s_waitcnt vmcnt(0)" ::: "memory");
}
typedef float f32x16 __attribute__((ext_vector_type(16)));
namespace ssm {
constexpr int SLOT = 52224, OFF_BU = 0, OFF_X = 32768, OFF_U = 49152;
typedef float f32x2v __attribute__((ext_vector_type(2)));
__device__ __forceinline__ f32x2v gelu2(f32x2v v) {
    f32x2v av; av.x = fabsf(v.x); av.y = fabsf(v.y);
    const f32x2v d = av * 0.2316418882f + 1.0f;
    f32x2v t; t.x = __builtin_amdgcn_rcpf(d.x); t.y = __builtin_amdgcn_rcpf(d.y);
    f32x2v q = t * 0.5307027145f + (-0.7265760135f); q = q * t + 0.7107068705f; q = q * t + (-0.142248368f); q = q * t + 0.127414796f; q = q * t;
    const f32x2v s = (av * av) * (-0.72134752044f);
    f32x2v e; e.x = __builtin_amdgcn_exp2f(s.x); e.y = __builtin_amdgcn_exp2f(s.y);
    const f32x2v m = av * (q * e);
    f32x2v r; r.x = fmaxf(v.x, 0.f); r.y = fmaxf(v.y, 0.f);
    return r - m;
}
__device__ __forceinline__ void pair(const Params& P, int itA, int itB, LAS unsigned char* lds, const bool hidden) {
    const float* lam_re = P.in[6]; const float* lam_im = P.in[7]; const float* log_dt = P.in[8];
    const float* b_re = P.in[9]; const float* b_im = P.in[10]; const float* c_re = P.in[11]; const float* c_im = P.in[12]; const float* d_skip = P.in[13];
    const bf16_t* U = (const bf16_t*)(P.ws + WS_U); bf16_t* YG = (bf16_t*)(P.ws + WS_YG);
    const int tid = threadIdx.x, lane = tid & 63, c32 = lane & 31, hh = lane >> 5, i16 = lane & 15, g4 = lane >> 4;
    const int w = __builtin_amdgcn_readfirstlane(tid >> 6);
    const int slot = w < 4 ? (w & 1) : ((w >> 1) & 1);
    const int role = w < 2 ? 1 : (w < 4 ? 0 : 2 + (w & 1));
    const int it = slot ? itB : itA;
    const bool live = it < NB * NG;
    const int b = live ? it / NG : 0, g = live ? it % NG : 0;
    LAS unsigned char* sb = lds + slot * SLOT;
    const bf16_t* ub = U + (size_t)(b * NG + g) * SEQ * GC;
    float ar = 0.f, ai = 0.f; bf16x8 bfr[2][2]; bf16x8 cfr[4]; f32x4 dsk = (f32x4){0.f, 0.f, 0.f, 0.f};
#pragma unroll
    for (int q = 0; q < 2; ++q) { bfr[q][0] = (bf16x8){0, 0, 0, 0, 0, 0, 0, 0}; bfr[q][1] = bfr[q][0]; }
#pragma unroll
    for (int ks = 0; ks < 4; ++ks) cfr[ks] = (bf16x8){0, 0, 0, 0, 0, 0, 0, 0};
    if (role < 2) {
        const float dt = expf(log_dt[g]);
#pragma unroll
        for (int q = 0; q < 2; ++q) {
            const int n = 32 * q + c32;
            const float lr = lam_re[g * NS + n], li = lam_im[g * NS + n];
            const float mag = expf(lr * dt); float sn, cs; sincosf(li * dt, &sn, &cs);
            const float a_r = mag * cs, a_i = mag * sn;
            const float dn = lr * lr + li * li, nr = a_r - 1.f;
            const float cr = (nr * lr + a_i * li) / dn, ci = (a_i * lr - nr * li) / dn;
            if (q == hh) { ar = a_r; ai = a_i; }
            const f32x4* brp = (const f32x4*)(b_re + (size_t)(g * NS + n) * GC + 8 * hh); const f32x4* bip = (const f32x4*)(b_im + (size_t)(g * NS + n) * GC + 8 * hh);
            const f32x4 br0 = brp[0], br1 = brp[1], bi0 = bip[0], bi1 = bip[1];
            const f32x4 re0 = br0 * cr - bi0 * ci, re1 = br1 * cr - bi1 * ci, im0 = bi0 * cr + br0 * ci, im1 = bi1 * cr + br1 * ci;
            u32x4 wre, wim;
            wre.x = cvtpk(re0[0], re0[1]); wre.y = cvtpk(re0[2], re0[3]); wre.z = cvtpk(re1[0], re1[1]); wre.w = cvtpk(re1[2], re1[3]);
            wim.x = cvtpk(im0[0], im0[1]); wim.y = cvtpk(im0[2], im0[3]); wim.z = cvtpk(im1[0], im1[1]); wim.w = cvtpk(im1[2], im1[3]);
            bfr[q][0] = __builtin_bit_cast(bf16x8, wre); bfr[q][1] = __builtin_bit_cast(bf16x8, wim);
        }
    } else {
#pragma unroll
        for (int ks = 0; ks < 4; ++ks) {
            const int n0 = 16 * ks + 4 * g4;
            const f32x4 cre = *(const f32x4*)(c_re + (size_t)(g * GC + i16) * NS + n0), cim = *(const f32x4*)(c_im + (size_t)(g * GC + i16) * NS + n0);
            u32x4 wc; wc.x = cvtpk(cre[0], -cim[0]); wc.y = cvtpk(cre[1], -cim[1]); wc.z = cvtpk(cre[2], -cim[2]); wc.w = cvtpk(cre[3], -cim[3]);
            cfr[ks] = __builtin_bit_cast(bf16x8, wc);
        }
        dsk = *(const f32x4*)(d_skip + g * GC + 4 * g4);
    }
    float xr = 0.f, xi = 0.f;
    const float a2r = ar * ar - ai * ai, a2i = 2.f * ar * ai;
    constexpr int NT = SEQ / 32;
#define SSM_BAR() do { asm volatile("s_waitcnt lgkmcnt(0)" ::: "memory"); __builtin_amdgcn_s_barrier(); asm volatile("" ::: "memory"); } while (0)
    if (role == 0) {
        const bf16_t* up = ub + c32 * GC + 8 * hh;
        constexpr int PF = 8;
        bf16x8 ua[PF];
#pragma unroll
        for (int i = 0; i < PF; ++i) ua[i] = __builtin_nontemporal_load((const bf16x8*)(up + (size_t)i * 32 * GC));
#define SSM_PRODUCE(step_, a_) do { \
            LAS unsigned char* wb = sb + OFF_BU + ((step_) & 1) * 16384; \
            *(LAS bf16x8*)(sb + OFF_U + ((step_) % 3) * 1024 + c32 * 32 + hh * 16) = (a_);     \
            _Pragma("unroll") for (int q = 0; q < 2; ++q) { \
                f32x16 z = {0.f, 0.f, 0.f, 0.f, 0.f, 0.f, 0.f, 0.f, 0.f, 0.f, 0.f, 0.f, 0.f, 0.f, 0.f, 0.f}; \
                const f32x16 dre = __builtin_amdgcn_mfma_f32_32x32x16_bf16((a_), bfr[q][0], z, 0, 0, 0); \
                const f32x16 dim = __builtin_amdgcn_mfma_f32_32x32x16_bf16((a_), bfr[q][1], z, 0, 0, 0); \
                _Pragma("unroll") for (int r = 0; r < 16; r += 2) { const int tau = (r & 3) + 8 * (r >> 2) + 4 * hh;     \
                    *(LAS f32x4*)(wb + (tau >> 1) * 1024 + 16 * (32 * q + c32)) = (f32x4){dre[r], dim[r], dre[r + 1], dim[r + 1]}; } \
            } } while (0)
        for (int step = 0; step < NT; step += PF) {
#pragma unroll
            for (int i = 0; i < PF; ++i) {
                SSM_PRODUCE(step + i, ua[i]);
                ua[i] = __builtin_nontemporal_load((const bf16x8*)(up + (size_t)(step + i + PF < NT ? step + i + PF : NT - 1) * 32 * GC));
                SSM_BAR();
            }
        }
        SSM_BAR(); SSM_BAR();
#undef SSM_PRODUCE
    } else if (role == 1) {
        unsigned xoff[2][16];
#pragma unroll
        for (int p = 0; p < 2; ++p)
#pragma unroll
            for (int k = 0; k < 16; ++k) xoff[p][k] = (unsigned)(OFF_X + p * 8192 + k * 256 + 16 * ((lane >> 2) ^ k) + 4 * (lane & 3));
#define SSM_SCAN(par_) do { \
            LAS const unsigned char* rb = sb + OFF_BU + (par_) * 16384 + 16 * lane; \
            f32x4 b2[16]; \
            _Pragma("unroll") for (int j = 0; j < 16; ++j) b2[j] = *(LAS const f32x4*)(rb + j * 1024);     \
            _Pragma("unroll") for (int j = 0; j < 16; ++j) { \
                { const float nr = fmaf(ar, xr, fmaf(-ai, xi, b2[j][0])); xi = fmaf(ar, xi, fmaf(ai, xr, b2[j][1])); xr = nr; } \
                *(LAS unsigned*)(sb + xoff[par_][(2 * j) & 15] + ((2 * j) >> 4) * 4096) = cvtpk(xr, xi); \
                { const float nr = fmaf(ar, xr, fmaf(-ai, xi, b2[j][2])); xi = fmaf(ar, xi, fmaf(ai, xr, b2[j][3])); xr = nr; } \
                *(LAS unsigned*)(sb + xoff[par_][(2 * j + 1) & 15] + ((2 * j + 1) >> 4) * 4096) = cvtpk(xr, xi); \
            } } while (0)
        __builtin_amdgcn_s_setprio(3);
        SSM_BAR();
        for (int step = 1; step <= NT; step += 2) {
            SSM_SCAN(0); SSM_BAR();
            SSM_SCAN(1); SSM_BAR();
        }
        SSM_BAR();
        __builtin_amdgcn_s_setprio(0);
#undef SSM_SCAN
    } else {
#define SSM_CONSUME(step_) do { \
            const int tile = (step_) - 2, tau = 16 * (role - 2) + i16, tok = tile * 32 + tau; \
            LAS const unsigned char* xb = sb + OFF_X + (tile & 1) * 8192; \
            const unsigned long long uw = *(LAS const unsigned long long*)(sb + OFF_U + (tile % 3) * 1024 + tau * 32 + g4 * 8); \
            f32x4 acc = (f32x4){0.f, 0.f, 0.f, 0.f}; \
            _Pragma("unroll") for (int ks = 0; ks < 4; ++ks) { \
                const bf16x8 xf = *(LAS const bf16x8*)(xb + tau * 256 + 16 * ((4 * ks + g4) ^ (tau & 15))); \
                acc = __builtin_amdgcn_mfma_f32_16x16x32_bf16(cfr[ks], xf, acc, 0, 0, 0); } \
            const unsigned u0 = (unsigned)uw, u1 = (unsigned)(uw >> 32); \
            const f32x2v ya = gelu2((f32x2v){acc[0] + dsk[0] * bflo(u0), acc[1] + dsk[1] * bfhi(u0)}), yb = gelu2((f32x2v){acc[2] + dsk[2] * bflo(u1), acc[3] + dsk[3] * bfhi(u1)}); \
            const float y0 = ya.x, y1 = ya.y, y2 = yb.x, y3 = yb.y; \
            if (live) *(unsigned long long*)(YG + ((size_t)b * SEQ + tok) * AW + g * GC + 4 * g4) = (unsigned long long)cvtpk(y0, y1) | ((unsigned long long)cvtpk(y2, y3) << 32); \
        } while (0)
        if (hidden && w >= 6) {
            const bf16_t* NUM = (const bf16_t*)(P.ws + WS_NUM); const float* DEN = (const float*)(P.ws + WS_DEN); const bf16_t* GA = (const bf16_t*)(P.ws + WS_GA);
            bf16_t* MIX = (bf16_t*)(P.ws + WS_MIX);
            const size_t hb0 = ((size_t)blockIdx.x * 4 + 2 * (w - 6)) * 64 + lane, hb1 = hb0 + 64, hstride = (size_t)gridDim.x * 256;
            u32x4 mn0[2][2], mn1[2][2], mn2[2][2], mga[2][2]; float md0[2][2], md1[2][2], md2[2][2];
            const f32x4* pin = (const f32x4*)P.in[1]; unsigned long long* PB8 = (unsigned long long*)(P.ws + WS_PB); f32x4 pvv[2];
#define HP_STEP(par_, j_, fin_, iss_) do { \
                if (fin_) { const size_t o_ = ((par_) ? hb1 : hb0) + (size_t)((j_) - 1) * hstride; __builtin_nontemporal_store((unsigned long long)cvtpk(pvv[par_].x, pvv[par_].y) | ((unsigned long long)cvtpk(pvv[par_].z, pvv[par_].w) << 32), PB8 + o_); } \
                if (iss_) pvv[par_] = __builtin_nontemporal_load(pin + ((par_) ? hb1 : hb0) + (size_t)(j_) * hstride); } while (0)
#define H_ISSUE_1(S_, k_, B_) do { const size_t i_ = ((S_) ? hb1 : hb0) + (size_t)(k_) * hstride; const int row_ = (int)(i_ >> 6), c8_ = (int)(i_ & 63) * 8, h_ = c8_ >> 6; \
                md0[S_][B_] = DEN[(size_t)row_ * NH + h_]; md1[S_][B_] = DEN[((size_t)T + row_) * NH + h_]; md2[S_][B_] = DEN[((size_t)2 * T + row_) * NH + h_]; \
                mn0[S_][B_] = *(const u32x4*)(NUM + (size_t)row_ * AW + c8_); mn1[S_][B_] = *(const u32x4*)(NUM + ((size_t)T + row_) * AW + c8_); mn2[S_][B_] = *(const u32x4*)(NUM + ((size_t)2 * T + row_) * AW + c8_); \
                mga[S_][B_] = __builtin_nontemporal_load((const u32x4*)(GA + (size_t)row_ * AW + c8_)); } while (0)
#define H_FINISH_1(S_, k_, B_) do { const size_t i_ = ((S_) ? hb1 : hb0) + (size_t)(k_) * hstride; const int row_ = (int)(i_ >> 6), c8_ = (int)(i_ & 63) * 8; \
                const float inv_ = __builtin_amdgcn_rcpf(md0[S_][B_] + md1[S_][B_] + md2[S_][B_]); u32x4 o_; \
                _Pragma("unroll") for (int j = 0; j < 4; ++j) { const float lo_ = (bflo(mn0[S_][B_][j]) + bflo(mn1[S_][B_][j]) + bflo(mn2[S_][B_][j])) * inv_ * bflo(mga[S_][B_][j]); \
                    const float hi_ = (bfhi(mn0[S_][B_][j]) + bfhi(mn1[S_][B_][j]) + bfhi(mn2[S_][B_][j])) * inv_ * bfhi(mga[S_][B_][j]); o_[j] = cvtpk(lo_, hi_); } \
                *(u32x4*)(MIX + (size_t)row_ * DM + c8_) = o_; } while (0)
#define H_ISSUE_M(k_, B_) do { H_ISSUE_1(0, k_, B_); H_ISSUE_1(1, k_, B_); } while (0)
#define H_FINISH_M(k_, B_) do { H_FINISH_1(0, k_, B_); H_FINISH_1(1, k_, B_); } while (0)
            HP_STEP(0, 0, false, true); SSM_BAR(); HP_STEP(1, 0, false, true); SSM_BAR();
            for (int j = 1; j < 4; ++j) { HP_STEP(0, j, true, true); SSM_CONSUME(2 * j); SSM_BAR(); HP_STEP(1, j, true, true); SSM_CONSUME(2 * j + 1); SSM_BAR(); }
            xcd_wait_wave((unsigned*)(P.ws + WS_CTL), (volatile LAS unsigned*)(lds + LDSCTL_OFF), lane);
            for (int m = 4; m < 32; m += 2) {
                if (m - 4 < MERGE_HIDDEN) H_ISSUE_M(m - 4, 0);
                HP_STEP(0, m, true, true); SSM_CONSUME(2 * m); SSM_BAR();
                if (m > 4 && m - 5 < MERGE_HIDDEN) H_FINISH_M(m - 5, 1);
                HP_STEP(1, m, true, true); SSM_CONSUME(2 * m + 1); SSM_BAR();
                if (m - 3 < MERGE_HIDDEN) H_ISSUE_M(m - 3, 1);
                HP_STEP(0, m + 1, true, true); SSM_CONSUME(2 * m + 2); SSM_BAR();
                if (m - 4 < MERGE_HIDDEN) H_FINISH_M(m - 4, 0);
                HP_STEP(1, m + 1, true, true); SSM_CONSUME(2 * m + 3); SSM_BAR();
            }
            HP_STEP(0, 32, true, false); SSM_CONSUME(64); SSM_BAR();
            if (27 < MERGE_HIDDEN) H_FINISH_M(27, 1);
            HP_STEP(1, 32, true, false); SSM_CONSUME(65); SSM_BAR();
#undef HP_STEP
#undef H_ISSUE_1
#undef H_FINISH_1
#undef H_ISSUE_M
#undef H_FINISH_M
        } else {
            SSM_BAR(); SSM_BAR();
            for (int step = 2; step < NT + 2; ++step) { SSM_CONSUME(step); SSM_BAR(); }
        }
#undef SSM_CONSUME
    }
#undef SSM_BAR
    wg_sync();
}
}
__device__ __forceinline__ void ph_ssm(const Params& P, LAS unsigned char* lds, const bool hidden) {
    for (int pr = (int)blockIdx.x; 2 * pr < NB * NG; pr += (int)gridDim.x) ssm::pair(P, 2 * pr, 2 * pr + 1, lds, hidden);
}
__device__ __forceinline__ void ph_merge(const Params& P, const Ctx& c) {
    unsigned char* ws = P.ws;
    const bf16_t* NUM = (const bf16_t*)(ws + WS_NUM); const float* DEN = (const float*)(ws + WS_DEN); const bf16_t* GA = (const bf16_t*)(ws + WS_GA); bf16_t* MIX = (bf16_t*)(ws + WS_MIX);
    for (size_t i = c.gtid; i < (size_t)T * 64; i += c.nthr) {
        const int row = (int)(i >> 6), c8 = (int)(i & 63) * 8, h = c8 >> 6;
        const float den = DEN[(size_t)row * NH + h] + DEN[((size_t)T + row) * NH + h] + DEN[((size_t)2 * T + row) * NH + h];
        const float inv = 1.0f / den;
        const u32x4 n0 = *(const u32x4*)(NUM + (size_t)row * AW + c8), n1 = *(const u32x4*)(NUM + ((size_t)T + row) * AW + c8), n2 = *(const u32x4*)(NUM + ((size_t)2 * T + row) * AW + c8);
        const u32x4 ga = *(const u32x4*)(GA + (size_t)row * AW + c8);
        u32x4 o;
#pragma unroll
        for (int j = 0; j < 4; ++j) { const float lo = (bflo(n0[j]) + bflo(n1[j]) + bflo(n2[j])) * inv * bflo(ga[j]); const float hi = (bfhi(n0[j]) + bfhi(n1[j]) + bfhi(n2[j])) * inv * bfhi(ga[j]); o[j] = pk2(lo, hi); }
        *(u32x4*)(MIX + (size_t)row * DM + c8) = o;
    }
}
__device__ __forceinline__ void ph_merge_rest(const Params& P) {
    unsigned char* ws = P.ws;
    const bf16_t* NUM = (const bf16_t*)(ws + WS_NUM); const float* DEN = (const float*)(ws + WS_DEN); const bf16_t* GA = (const bf16_t*)(ws + WS_GA); bf16_t* MIX = (bf16_t*)(ws + WS_MIX);
    const int w = (int)threadIdx.x >> 6, lane = (int)threadIdx.x & 63;
    const size_t hbase = ((size_t)blockIdx.x * 4 + (w & 3)) * 64 + lane, hstride = (size_t)gridDim.x * 256;
#pragma unroll 4
    for (int k = MERGE_HIDDEN + (w >> 2); k < 32; k += 2) {
        const size_t i = hbase + (size_t)k * hstride; const int row = (int)(i >> 6), c8 = (int)(i & 63) * 8, h = c8 >> 6;
        const float den = DEN[(size_t)row * NH + h] + DEN[((size_t)T + row) * NH + h] + DEN[((size_t)2 * T + row) * NH + h];
        const float inv = __builtin_amdgcn_rcpf(den);
        const u32x4 n0 = *(const u32x4*)(NUM + (size_t)row * AW + c8), n1 = *(const u32x4*)(NUM + ((size_t)T + row) * AW + c8), n2 = *(const u32x4*)(NUM + ((size_t)2 * T + row) * AW + c8);
        const u32x4 ga = __builtin_nontemporal_load((const u32x4*)(GA + (size_t)row * AW + c8));
        u32x4 o;
#pragma unroll
        for (int j = 0; j < 4; ++j) { const float lo = (bflo(n0[j]) + bflo(n1[j]) + bflo(n2[j])) * inv * bflo(ga[j]); const float hi = (bfhi(n0[j]) + bfhi(n1[j]) + bfhi(n2[j])) * inv * bfhi(ga[j]); o[j] = cvtpk(lo, hi); }
        *(u32x4*)(MIX + (size_t)row * DM + c8) = o;
    }
}
constexpr int XCNT_WORD0 = 3456 + 64;
struct InOrder : pg8::StaticOrder {
    const float* x; bf16_t* XB; float* rr; unsigned* cnt; int stag, slot, row0, lane;
    __device__ __forceinline__ void a_ready(const pg8::Unit& u) const {
        if (stag && (u.pm & 15) >= 8 && u.pn < 4) {
            if (threadIdx.x < 64) {
                unsigned sp = 0u;
                while ((unsigned)__builtin_amdgcn_readfirstlane(__hip_atomic_load(cnt, __ATOMIC_RELAXED, __HIP_MEMORY_SCOPE_AGENT)) < 256u) { __builtin_amdgcn_s_sleep(2); if (++sp > (1u << 20)) break; }
                __builtin_amdgcn_fence(__ATOMIC_ACQUIRE, "agent");
                asm volatile("s_waitcnt vmcnt(0)" ::: "memory");
            }
            asm volatile("" ::: "memory"); __builtin_amdgcn_s_barrier(); asm volatile("" ::: "memory");
        }
    }
    __device__ __forceinline__ void done(const pg8::Unit& u) const {
        if (stag && (u.pm & 15) < 8 && (u.pn >> 2) == slot) {
            convert_rows_wt(x, XB, rr, row0, lane);
            if (lane == 0) __hip_atomic_fetch_add(cnt, 1u, __ATOMIC_RELAXED, __HIP_MEMORY_SCOPE_AGENT);
        }
    }
};
__device__ __forceinline__ void ph_inproj(const Params& P, LAS unsigned char* lds) {
    unsigned char* ws = P.ws;
    pg8::Gemm g{(const bf16_t*)(ws + WS_XB), (const bf16_t*)(ws + WS_WINT), T, INW, DM}; InOrder S; S.init(T, INW, (int)gridDim.x, (int)blockIdx.x);
    const int c = (int)blockIdx.x, lbl = c & 7, w = (int)threadIdx.x >> 6;
    S.x = P.in[0]; S.XB = (bf16_t*)(ws + WS_XB); S.rr = (float*)(ws + WS_RRMSX); S.cnt = (unsigned*)(ws + WS_CTL) + XCNT_WORD0 + 64 * lbl;
    S.stag = gridDim.x == 256; S.slot = (c >> 3) & 1; S.lane = (int)threadIdx.x & 63;
    S.row0 = (16 * lbl + 8) * 256 + ((c >> 3) * 8 + w) * 8;
    pg8::EpiInProj E{(const float*)(ws + WS_RRMSX), P.in[4], P.in[5], (bf16_t*)(ws + WS_Q), (bf16_t*)(ws + WS_K), (bf16_t*)(ws + WS_V), (bf16_t*)(ws + WS_GA), (bf16_t*)(ws + WS_GS), (bf16_t*)(ws + WS_U)};
    pg8::gemm_phase<pg8::EpiInProj, InOrder, true, true>(lds, g, S, E);
}
__device__ __forceinline__ void ph_glu(const Params& P, LAS unsigned char* lds) {
    unsigned char* ws = P.ws;
    pg8::Gemm g{(const bf16_t*)(ws + WS_YG), (const bf16_t*)(ws + WS_WGLUT), T, AW, AW}; pg8::StaticOrder S; S.init(T, AW, (int)gridDim.x, (int)blockIdx.x);
    pg8::EpiGlu E{P.in[15], (const bf16_t*)(ws + WS_YG), (const bf16_t*)(ws + WS_GS), (bf16_t*)(ws + WS_MIX)};
    pg8::gemm_phase<pg8::EpiGlu, pg8::StaticOrder, true, true>(lds, g, S, E);
}
__device__ __forceinline__ void gemm_out(const Params& P, LAS unsigned char* lds) {
    unsigned char* ws = P.ws;
    pg8::Gemm g{(const bf16_t*)(ws + WS_MIX), (const bf16_t*)(ws + WS_WOUTT), T, DM, DM}; pg8::StaticOrder S; S.init(T, DM, (int)gridDim.x, (int)blockIdx.x);
    pg8::EpiOut E{(const bf16_t*)(ws + WS_XB), (bf16_t*)(ws + WS_HB), (float*)(ws + WS_SSPART)};
    pg8::gemm_phase<pg8::EpiOut, pg8::StaticOrder, true, true>(lds, g, S, E);
}
struct SubOrder {
    pg8::StaticOrder S; int first, count;
    __device__ __forceinline__ bool next(int i, pg8::Unit& u) const { return i < count && S.next(first + i, u); }
    __device__ __forceinline__ void a_ready(const pg8::Unit&) const {}
    __device__ __forceinline__ void done(const pg8::Unit&) const {}
};
__device__ __forceinline__ void gemm_proj(const Params& P, LAS unsigned char* lds, int first, int count) {
    unsigned char* ws = P.ws;
    pg8::Gemm g{(const bf16_t*)(ws + WS_PB), (const bf16_t*)(ws + WS_WPT), T, DM, PLE}; SubOrder S; S.S.init(T, DM, (int)gridDim.x, (int)blockIdx.x); S.first = first; S.count = count;
    pg8::EpiProj E{(bf16_t*)(ws + WS_PROJ)};
    pg8::gemm_phase<pg8::EpiProj, SubOrder, true, true>(lds, g, S, E);
}
__device__ __forceinline__ void ph_outproj(const Params& P, LAS unsigned char* lds) {
    gemm_out(P, lds);
}
__device__ __forceinline__ void ph_gate(const Params& P, LAS unsigned char* lds) {
    unsigned char* ws = P.ws;
    pg8::Gemm g{(const bf16_t*)(ws + WS_HB), (const bf16_t*)(ws + WS_WGT), T, DM, DM}; pg8::StaticOrder S; S.init(T, DM, (int)gridDim.x, (int)blockIdx.x);
    { float* RRH = (float*)(ws + WS_RRMSH); const float* SSP = (const float*)(ws + WS_SSPART); pg8::Unit u;
      for (int i = 0; S.next(i, u); ++i)
          for (int rr = (int)threadIdx.x; rr < 256; rr += 512) { const int r = u.pm * 256 + rr; const f32x4* sp = (const f32x4*)(SSP + (size_t)r * 16); const f32x4 t4 = (sp[0] + sp[1]) + (sp[2] + sp[3]);
              RRH[r] = __builtin_amdgcn_rsqf(((t4[0] + t4[1]) + (t4[2] + t4[3])) * (1.f / DM) + EPS); }
      wg_sync(); }
    pg8::EpiGate E{(const float*)(ws + WS_RRMSH), (const bf16_t*)(ws + WS_PROJ), (const bf16_t*)(ws + WS_HB), P.out};
    pg8::gemm_phase<pg8::EpiGate, pg8::StaticOrder, true, true>(lds, g, S, E);
}

constexpr int CTL_INIT_WORDS = XCD_BAR_WORDS + 64 + 8 * 64, CTL_FLAG_WORD = CTL_INIT_WORDS + 64; constexpr unsigned CTL_MAGIC = 0x13572468u;
constexpr int NPHASE = 6;
__global__ void __launch_bounds__(512, 2) mega(Params P) {
    extern __shared__ __attribute__((aligned(16))) unsigned char lds_raw[];
    LAS unsigned char* lds = (LAS unsigned char*)lds_raw;
    Ctx c; c.lane = threadIdx.x & 63; c.gtid = blockIdx.x * 512 + threadIdx.x; c.nthr = gridDim.x * 512; c.gwave = c.gtid >> 6; c.nwaves = c.nthr >> 6;
    cg::grid_group grid = cg::this_grid();
    volatile LAS unsigned* xbst = (volatile LAS unsigned*)(lds + LDSCTL_OFF);
    if (threadIdx.x < 4) xbst[threadIdx.x] = 0u;
    wg_sync();
    { unsigned* ctl = (unsigned*)(P.ws + WS_CTL);
      if (blockIdx.x == 0) {
          for (int i = (int)threadIdx.x; i < CTL_INIT_WORDS; i += 512) __hip_atomic_store(ctl + i, 0u, __ATOMIC_RELAXED, __HIP_MEMORY_SCOPE_AGENT);
          asm volatile("s_waitcnt vmcnt(0)" ::: "memory");
          wg_sync();
          if (threadIdx.x == 0) { __builtin_amdgcn_fence(__ATOMIC_RELEASE, "agent"); asm volatile("s_waitcnt vmcnt(0)" ::: "memory"); __hip_atomic_store(ctl + CTL_FLAG_WORD, CTL_MAGIC, __ATOMIC_RELAXED, __HIP_MEMORY_SCOPE_AGENT); }
      }
      if (threadIdx.x == 0) {
          unsigned sp = 0u;
          while (__hip_atomic_load(ctl + CTL_FLAG_WORD, __ATOMIC_RELAXED, __HIP_MEMORY_SCOPE_AGENT) != CTL_MAGIC) { __builtin_amdgcn_s_sleep(1); if (++sp > (1u << 22)) break; }
          __builtin_amdgcn_fence(__ATOMIC_ACQUIRE, "agent");
      }
      wg_sync(); }
    XcdBarrier xbar = xcd_barrier_post((unsigned*)(P.ws + WS_CTL), xbst);
    const int lo = P.ph_lo, hi = P.ph_hi;
#define IN(k) (lo <= (k) && (k) < hi)
#define SEAM(k) do { if (IN(k) && IN((k) + 1)) { if (P.use_cg) grid.sync(); else xcd_barrier(xbar); } } while (0)
#ifndef REP
#define REP -1
#endif
#define RUN(k, body) do { if (IN(k)) { body; if (REP == (k)) { wg_sync(); body; } } } while (0)
#define ARRIVE(k) do { if (IN(k) && IN((k) + 1) && !P.use_cg) xcd_arrive(xbar); } while (0)
#define WAIT(k) do { if (IN(k) && IN((k) + 1)) { if (P.use_cg) grid.sync(); else xcd_wait(xbar); } } while (0)
    RUN(0, ph_prep(P, c, lds));
    ARRIVE(0);
    if (IN(1)) { ph_prep_late(P, c, lds, 0); wg_sync(); }
    WAIT(0);
    RUN(1, ph_inproj(P, lds));
    ARRIVE(1);
    if (IN(2)) { ph_prep_late(P, c, lds, 1); wg_sync(); }
    WAIT(1);
    const bool hid = (gridDim.x == 256) && IN(2) && IN(3);
    if (IN(2)) {
        ph_attn(P, lds);
        if (hid) xcd_arrive(xbar); else ph_prep_p(P, c);
        ph_ssm(P, lds, hid);
    }
    ARRIVE(2);
    if (hid) ph_merge_rest(P);
    WAIT(2);
    if (IN(3)) { if (hid) ph_glu(P, lds); else if (blockIdx.x & 1) { ph_glu(P, lds); ph_merge(P, c); } else { ph_merge(P, c); ph_glu(P, lds); } }
    ARRIVE(3);
    if (IN(4)) gemm_proj(P, lds, 0, 1);
    WAIT(3);
    RUN(4, ph_outproj(P, lds));
    ARRIVE(4);
    if (IN(4)) gemm_proj(P, lds, 1, 1 << 20);
    WAIT(4);
    if (IN(5)) ph_gate(P, lds);
    if (blockIdx.x == 0 && threadIdx.x == 0) __hip_atomic_store((unsigned*)(P.ws + WS_CTL) + CTL_FLAG_WORD, 0u, __ATOMIC_RELAXED, __HIP_MEMORY_SCOPE_AGENT);
    if (REP == 45) { xcd_barrier(xbar); ph_outproj(P, lds); xcd_barrier(xbar); ph_gate(P, lds); }
#undef IN
#undef SEAM
}

extern "C" void kernel_launch(void* const* d_in, const int* in_sizes, int n_in, void* d_out, int out_size, void* d_ws, size_t ws_size, hipStream_t stream) {
    static int grid = 0;
    if (grid == 0) {
        int dev = 0, cus = 0, per_cu = 0;
        (void)hipGetDevice(&dev); (void)hipDeviceGetAttribute(&cus, hipDeviceAttributeMultiprocessorCount, dev);
        if (hipFuncSetAttribute((const void*)mega, hipFuncAttributeMaxDynamicSharedMemorySize, LDS_BYTES) != hipSuccess) fprintf(stderr, "kernel_launch: hipFuncSetAttribute failed\n");
        (void)hipOccupancyMaxActiveBlocksPerMultiprocessor(&per_cu, (const void*)mega, 512, LDS_BYTES);
        if (per_cu < 1) { fprintf(stderr, "kernel_launch: occupancy query says %d blocks per CU\n", per_cu); per_cu = 1; }
        grid = cus;
        if (n_in != 20 || ws_size < WS_END) { fprintf(stderr, "kernel_launch: unexpected n_in %d / ws %zu\n", n_in, ws_size); }
    }
    Params p{};
    for (int i = 0; i < 20; ++i) p.in[i] = (const float*)d_in[i];
    p.out = (float*)d_out; p.ws = (unsigned char*)d_ws;
#if N_LAUNCH == 1
    p.ph_lo = 0; p.ph_hi = NPHASE;
    void* args[] = {&p};
    hipError_t e = hipLaunchCooperativeKernel((const void*)mega, dim3(grid), dim3(512), args, LDS_BYTES, stream);
    if (e != hipSuccess) fprintf(stderr, "cooperative launch failed: %s (grid %d)\n", hipGetErrorString(e), grid);
#else
    for (int ph = 0; ph < NPHASE; ++ph) { p.ph_lo = ph; p.ph_hi = ph + 1; hipLaunchKernelGGL(mega, dim3(grid), dim3(512), LDS_BYTES, stream, p); }
#endif
}
```
